# Optimizing an MI355X kernel written in HIP

```python
import jax, jax.numpy as jnp
from jax import lax
import numpy as np

D_MODEL = 1024
BATCH = 8
SEQ = 8192
DEPTH = 1

GRID_W = 64
HEAD_DIM = 64
A_HEADS = D_MODEL // (2 * HEAD_DIM)
A_KV_HEADS = A_HEADS // 4
A_WINDOW = 128
A_BLOCK = 128
B_HEADS = D_MODEL // (2 * HEAD_DIM)
B_KH_MAX = 8
B_KW = 16
D_FF = 4 * D_MODEL
EPS = 1e-6
A_WIDTH = A_HEADS * HEAD_DIM
A_KV_WIDTH = A_KV_HEADS * HEAD_DIM
B_WIDTH = B_HEADS * HEAD_DIM
IN_WIDTH = A_WIDTH + 2 * A_KV_WIDTH + 3 * B_WIDTH + 2 * D_MODEL

kernel_name = "hybrid_window_gqa_natten_gated_encoder"


def rms_norm(x, g):
    xf = x.astype(jnp.float32)
    var = jnp.mean(xf * xf, axis=-1, keepdims=True)
    return (xf * lax.rsqrt(var + EPS)).astype(x.dtype) * g


def alibi_slopes(n):
    return 2.0 ** (-8.0 * jnp.arange(1, n + 1, dtype=jnp.float32) / n)


def windowed_gqa(q, k, v, sink):
    b, s, _, d = q.shape
    nb = s // A_BLOCK
    grp = A_HEADS // A_KV_HEADS
    qb = q.reshape(b, nb, A_BLOCK, A_KV_HEADS, grp, d)
    pad = ((0, 0), (A_BLOCK, A_BLOCK), (0, 0), (0, 0))
    kp = jnp.pad(k, pad)
    vp = jnp.pad(v, pad)
    slopes = alibi_slopes(A_HEADS).reshape(A_KV_HEADS, grp)
    sink_f = sink.astype(jnp.float32).reshape(A_KV_HEADS, grp)
    scale = d ** -0.5

    def block(i):
        qi = qb[:, i]
        ki = lax.dynamic_slice_in_dim(kp, i * A_BLOCK, 3 * A_BLOCK, axis=1)
        vi = lax.dynamic_slice_in_dim(vp, i * A_BLOCK, 3 * A_BLOCK, axis=1)
        q_pos = i * A_BLOCK + jnp.arange(A_BLOCK)
        k_pos = (i - 1) * A_BLOCK + jnp.arange(3 * A_BLOCK)
        dist = jnp.abs(q_pos[:, None] - k_pos[None, :])
        valid = (dist <= A_WINDOW) & (k_pos[None, :] >= 0) & (k_pos[None, :] < s)
        sc = jnp.einsum('bqkgd,bskd->bkgqs', qi, ki).astype(jnp.float32) * scale
        sc = sc - slopes[:, :, None, None] * dist.astype(jnp.float32)
        sc = jnp.where(valid, sc, -jnp.inf)
        sink_col = jnp.broadcast_to(sink_f[None, :, :, None, None], sc.shape[:-1] + (1,))
        p = jax.nn.softmax(jnp.concatenate([sc, sink_col], axis=-1), axis=-1)[..., :-1]
        return jnp.einsum('bkgqs,bskd->bqkgd', p.astype(v.dtype), vi)

    out = lax.map(block, jnp.arange(nb))
    return jnp.moveaxis(out, 0, 1).reshape(b, s, A_WIDTH)


def neighborhood_attn(q, k, v, rpb):
    b, s, h, d = q.shape
    rows = s // GRID_W
    kh = min(B_KH_MAX, rows)
    qg = q.reshape(b, rows, GRID_W, h, d)
    kg = k.reshape(b, rows, GRID_W, h, d)
    vg = v.reshape(b, rows, GRID_W, h, d)
    cols = jnp.arange(GRID_W)
    col_start = jnp.clip(cols - B_KW // 2, 0, GRID_W - B_KW)
    col_idx = col_start[:, None] + jnp.arange(B_KW)[None, :]
    dc = col_idx - cols[:, None] + (B_KW - 1)
    rpb_f = rpb.astype(jnp.float32)
    scale = d ** -0.5

    def row(r):
        r0 = jnp.clip(r - kh // 2, 0, rows - kh)
        kr = lax.dynamic_slice_in_dim(kg, r0, kh, axis=1)
        vr = lax.dynamic_slice_in_dim(vg, r0, kh, axis=1)
        kn = kr[:, :, col_idx]
        vn = vr[:, :, col_idx]
        qr = lax.dynamic_index_in_dim(qg, r, axis=1, keepdims=False)
        sc = jnp.einsum('bchd,brckhd->bhcrk', qr, kn).astype(jnp.float32) * scale
        dr = r0 + jnp.arange(kh) - r + (B_KH_MAX - 1)
        bias = rpb_f[:, dr[:, None, None], dc[None, :, :]]
        sc = sc + jnp.transpose(bias, (0, 2, 1, 3))[None]
        p = jax.nn.softmax(sc.reshape(b, h, GRID_W, kh * B_KW), axis=-1)
        p = p.reshape(b, h, GRID_W, kh, B_KW).astype(v.dtype)
        return jnp.einsum('bhcrk,brckhd->bchd', p, vn)

    out = lax.map(row, jnp.arange(rows))
    return jnp.moveaxis(out, 0, 1).reshape(b, s, B_WIDTH)


def setup_inputs(seed: int = 0) -> dict:
    key = jax.random.key(seed)
    ks = jax.random.split(key, 14)
    f32 = jnp.float32

    def nrm(k, shape, scale):
        return jax.random.normal(k, shape, f32) * scale

    return {
        "x": nrm(ks[0], (BATCH, SEQ, D_MODEL), 1.0),
        "norm_mix": 1.0 + nrm(ks[1], (DEPTH, D_MODEL), 0.02),
        "w_in": nrm(ks[2], (DEPTH, D_MODEL, IN_WIDTH), D_MODEL ** -0.5),
        "b_gate": nrm(ks[3], (DEPTH, 2 * D_MODEL), 0.01),
        "sink": nrm(ks[4], (DEPTH, A_HEADS), 0.5),
        "rpb": nrm(ks[5], (DEPTH, B_HEADS, 2 * B_KH_MAX - 1, 2 * B_KW - 1), 0.1),
        "w_proj_a": nrm(ks[6], (DEPTH, A_WIDTH, D_MODEL), A_WIDTH ** -0.5),
        "w_proj_b": nrm(ks[7], (DEPTH, B_WIDTH, D_MODEL), B_WIDTH ** -0.5),
        "w_out": nrm(ks[8], (DEPTH, D_MODEL, D_MODEL), D_MODEL ** -0.5),
        "norm_mlp": 1.0 + nrm(ks[9], (DEPTH, D_MODEL), 0.02),
        "w_up": nrm(ks[10], (DEPTH, D_MODEL, D_FF), D_MODEL ** -0.5),
        "w_down": nrm(ks[11], (DEPTH, D_FF, D_MODEL), D_FF ** -0.5),
        "norm_final": 1.0 + nrm(ks[12], (D_MODEL,), 0.02),
    }


def reference(x, norm_mix, w_in, b_gate, sink, rpb, w_proj_a, w_proj_b, w_out,
              norm_mlp, w_up, w_down, norm_final):
    b, s, _ = x.shape
    sizes = [A_WIDTH, A_KV_WIDTH, A_KV_WIDTH, B_WIDTH, B_WIDTH, B_WIDTH, D_MODEL, D_MODEL]
    offsets = [int(o) for o in np.cumsum(sizes)[:-1]]
    for l in range(DEPTH):
        h = rms_norm(x, norm_mix[l])
        z = h @ w_in[l]
        q_a, k_a, v_a, q_b, k_b, v_b, g_a, g_b = jnp.split(z, offsets, axis=-1)
        y_a = windowed_gqa(q_a.reshape(b, s, A_HEADS, HEAD_DIM),
                           k_a.reshape(b, s, A_KV_HEADS, HEAD_DIM),
                           v_a.reshape(b, s, A_KV_HEADS, HEAD_DIM), sink[l])
        y_b = neighborhood_attn(q_b.reshape(b, s, B_HEADS, HEAD_DIM),
                                k_b.reshape(b, s, B_HEADS, HEAD_DIM),
                                v_b.reshape(b, s, B_HEADS, HEAD_DIM), rpb[l])
        gates = jax.nn.sigmoid((jnp.concatenate([g_a, g_b], axis=-1) + b_gate[l])
                               .astype(jnp.float32)).astype(x.dtype)
        merged = (gates[..., :D_MODEL] * (y_a @ w_proj_a[l])
                  + gates[..., D_MODEL:] * (y_b @ w_proj_b[l]))
        x = x + merged @ w_out[l]
        h2 = rms_norm(x, norm_mlp[l])
        x = x + jnp.square(jax.nn.relu(h2 @ w_up[l])) @ w_down[l]
    return rms_norm(x, norm_final)
```

```cpp
#include <hip/hip_runtime.h>
#include <hip/hip_cooperative_groups.h>
#include <cstdio>
#include <cstdint>
namespace cg = cooperative_groups;
namespace pg8 {
#define PG8_LAS __attribute__((address_space(3)))
typedef unsigned short bf16_t;
typedef short bf16x8 __attribute__((ext_vector_type(8)));
typedef float f32x4 __attribute__((ext_vector_type(4)));
typedef unsigned u32x4 __attribute__((ext_vector_type(4)));
constexpr int BM = 256, BK = 64, HALF = 128, HTB = HALF * BK * 2  , STAGE_BYTES = 8 * HTB, NXCD = 8, WGM = 8;

__host__ __device__ __forceinline__ int lds_byte(int r, int c) { const int st = (r >> 4) * 2 + (c >> 5), rr = r & 15, cc = c & 31, ob = rr * 64 + cc * 2; return st * 1024 + (ob ^ (((ob >> 9) & 1) << 5)); }
__host__ __device__ __forceinline__ void stage_rc(int b, int& R, int& C) { const int st = b / 1024, sb = b % 1024, swz = sb ^ (((sb >> 9) & 1) << 5); R = (st >> 1) * 16 + swz / 64; C = (st & 1) * 32 + (swz % 64) / 2; }
__host__ __device__ __forceinline__ int perm32(int rho) { const int n = rho >> 4, i = rho & 15; return 8 * (i >> 2) + 4 * n + (i & 3); }

struct Unit { int pm, pn; };
struct Gemm { const bf16_t* A; const bf16_t* Bt; int M, N, K; };

struct StaticOrder {
    int nM, nN, nwg, G, c;
    __host__ __device__ void init(int M, int N, int G_, int c_) { nM = M / BM; nN = N / BM; nwg = nM * nN; G = G_; c = c_; }
    __host__ __device__ bool next(int i, Unit& u) const {
        const long L = (long)i * G + c; if (L >= nwg) return false;
        int wgid = (int)L; { const int q = nwg / NXCD, r = nwg % NXCD, xcd = wgid % NXCD, off = wgid / NXCD; wgid = (xcd < r ? xcd * (q + 1) : r * (q + 1) + (xcd - r) * q) + off; }
        const int nig = WGM * nN, gid = wgid / nig, fm = gid * WGM, gsz = (nM - fm) < WGM ? (nM - fm) : WGM;
        u.pm = fm + ((wgid % nig) % gsz); u.pn = (wgid % nig) / gsz; return true;
    }
    __device__ __forceinline__ void a_ready(const Unit&) const {}
    __device__ __forceinline__ void done(const Unit&) const {}
};

__device__ __forceinline__ unsigned cvt_pk_bf16(float lo, float hi) { unsigned r; asm volatile("v_cvt_pk_bf16_f32 %0, %1, %2" : "=v"(r) : "v"(lo), "v"(hi)); return r; }
typedef float f32x2 __attribute__((ext_vector_type(2)));
typedef unsigned u32x2 __attribute__((ext_vector_type(2)));
__device__ __forceinline__ float bf_lo(unsigned w) { return __uint_as_float(w << 16); }
__device__ __forceinline__ float bf_hi(unsigned w) { return __uint_as_float(w & 0xffff0000u); }
__device__ __forceinline__ size_t tm_block(int pm, int ct, int nct) { return ((size_t)pm * nct + ct) * 32768; }
__device__ __forceinline__ int tm_lane(int wr, int fr, int fq) { return (wr * 64 + fr) * 128 + fq * 16; }
#define TM_PIECE(ai, m, bj) ((ai) * 16384 + (m) * 2048 + (bj) * 64)
__device__ __forceinline__ u32x4 pack8(const f32x4& v0, const f32x4& v1) { u32x4 w; w.x = cvt_pk_bf16(v0[0], v0[1]); w.y = cvt_pk_bf16(v0[2], v0[3]); w.z = cvt_pk_bf16(v1[0], v1[1]); w.w = cvt_pk_bf16(v1[2], v1[3]); return w; }
#define UNPK0(q_) ((f32x4){bf_lo((q_).x), bf_hi((q_).x), bf_lo((q_).y), bf_hi((q_).y)})
#define UNPK1(q_) ((f32x4){bf_lo((q_).z), bf_hi((q_).z), bf_lo((q_).w), bf_hi((q_).w)})

#define PG8_SCR_STRIDE 144
#define PG8_SCR_WAVE 2304
struct PieceOut { PG8_LAS unsigned char* wp; const PG8_LAS unsigned char* rp; unsigned char* ob;
    __device__ __forceinline__ PieceOut(PG8_LAS unsigned char* scr, void* O, size_t block, int wr, int wc, int fr, int fq) {
        const int lane = fq * 16 + fr; PG8_LAS unsigned char* my = scr + (wr * 4 + wc) * PG8_SCR_WAVE;
        wp = my + fr * PG8_SCR_STRIDE + fq * 16; rp = my + (lane >> 3) * PG8_SCR_STRIDE + (lane & 7) * 16; ob = (unsigned char*)O + block + (size_t)(wr * 64) * 128 + lane * 16; }
    __device__ __forceinline__ void put(int bj, const u32x4& w) const { *(PG8_LAS u32x4*)(wp + bj * 64) = w; }
    template <bool NT> __device__ __forceinline__ void flush(int ai, int m) const {
        const u32x4 r0 = *(const PG8_LAS u32x4*)rp, r1 = *(const PG8_LAS u32x4*)(rp + 8 * PG8_SCR_STRIDE);
        u32x4* p = (u32x4*)(ob + ai * 16384 + m * 2048);
        if (NT) { __builtin_nontemporal_store(r0, p); __builtin_nontemporal_store(r1, p + 64); } else { *p = r0; *(p + 64) = r1; } }
};
struct PieceIn { PG8_LAS unsigned char* wp; PG8_LAS unsigned char* rp; const unsigned char* ib;
    __device__ __forceinline__ PieceIn(PG8_LAS unsigned char* scr, const void* I, size_t block, int wr, int wc, int fr, int fq) {
        const int lane = fq * 16 + fr; PG8_LAS unsigned char* my = scr + (wr * 4 + wc) * PG8_SCR_WAVE;
        wp = my + fr * PG8_SCR_STRIDE + fq * 16; rp = my + (lane >> 3) * PG8_SCR_STRIDE + (lane & 7) * 16; ib = (const unsigned char*)I + block + (size_t)(wr * 64) * 128 + lane * 16; }
    __device__ __forceinline__ void fetch(int ai, int m, u32x4& raw0, u32x4& raw1) const { const u32x4* p = (const u32x4*)(ib + ai * 16384 + m * 2048); raw0 = *p; raw1 = *(p + 64); }
    __device__ __forceinline__ void stage(const u32x4& raw0, const u32x4& raw1) const { *(PG8_LAS u32x4*)rp = raw0; *(PG8_LAS u32x4*)(rp + 8 * PG8_SCR_STRIDE) = raw1; }
    __device__ __forceinline__ u32x4 get(int bj) const { return *(const PG8_LAS u32x4*)(wp + bj * 64); }
};
struct EpiPlain {
    static constexpr bool PERM = true, AFTER_DRAIN = false, HAS_MID = false, HAS_PRE = false;
    bf16_t* O; int nct; PG8_LAS unsigned char* scr;
    __device__ __forceinline__ void operator()(const f32x4 (&acc)[2][2][4][2], const Unit& u, int wr, int wc, int fr, int fq) const {
        const PieceOut po(scr, O, tm_block(u.pm, u.pn * 4 + wc, nct), wr, wc, fr, fq);
#pragma unroll
        for (int ai = 0; ai < 2; ++ai)
#pragma unroll
            for (int m = 0; m < 4; ++m) { po.put(0, pack8(acc[ai][0][m][0], acc[ai][0][m][1])); po.put(1, pack8(acc[ai][1][m][0], acc[ai][1][m][1])); po.flush<true>(ai, m); }
    }
};
struct EpiGate2 {
    static constexpr bool PERM = true, AFTER_DRAIN = false, HAS_MID = true, HAS_PRE = false;
    bf16_t* O; const bf16_t* Z; int znct; int ga_ct, gb_ct; const float* bg; PG8_LAS unsigned char* scr;
    static __device__ __forceinline__ float eneg(float g) { return __builtin_amdgcn_exp2f(-1.4426950408889634f * fminf(fmaxf(g, -30.f), 30.f)); }
    __device__ __forceinline__ void mid(f32x4 (&acc)[2][2][4][2], const Unit& u, int wr, int wc, int fr, int fq) const {
        int pm = u.pm, cb = u.pn * 4 + wc;
        asm volatile("" : "+v"(pm), "+v"(cb));
        const PieceIn pa(scr, Z, tm_block(pm, ga_ct + cb, znct), wr, wc, fr, fq), pb(scr, Z, tm_block(pm, gb_ct + cb, znct), wr, wc, fr, fq);
        const int col0 = cb * 64 + 8 * fq;
        f32x4 ba[2][2], bb[2][2];
#pragma unroll
        for (int bj = 0; bj < 2; ++bj) { ba[bj][0] = *(const f32x4*)(bg + col0 + bj * 32); ba[bj][1] = *(const f32x4*)(bg + col0 + bj * 32 + 4); bb[bj][0] = *(const f32x4*)(bg + 1024 + col0 + bj * 32); bb[bj][1] = *(const f32x4*)(bg + 1024 + col0 + bj * 32 + 4); }
#pragma unroll
        for (int am = 0; am < 4; ++am) { const int ai = am >> 1;
            u32x4 ra[4][2], rb[4][2];
#pragma unroll
            for (int m = 2 * (am & 1); m < 2 * (am & 1) + 2; ++m) { pa.fetch(ai, m, ra[m][0], ra[m][1]); pb.fetch(ai, m, rb[m][0], rb[m][1]); }
            asm volatile("" ::: "memory");
#pragma unroll
            for (int m = 2 * (am & 1); m < 2 * (am & 1) + 2; ++m) {
                pa.stage(ra[m][0], ra[m][1]); const u32x4 ga0 = pa.get(0), ga1 = pa.get(1);
                asm volatile("" ::: "memory");
                pb.stage(rb[m][0], rb[m][1]); const u32x4 gb0 = pb.get(0), gb1 = pb.get(1);
                asm volatile("" ::: "memory");
#pragma unroll
                for (int bj = 0; bj < 2; ++bj) { const u32x4 ga = bj ? ga1 : ga0, gb = bj ? gb1 : gb0;
                    const f32x4 a0 = UNPK0(ga) + ba[bj][0], a1 = UNPK1(ga) + ba[bj][1], b0 = UNPK0(gb) + bb[bj][0], b1 = UNPK1(gb) + bb[bj][1];
#pragma unroll
                    for (int k = 0; k < 4; ++k) { acc[ai][bj][m][0][k] *= (1.0f + eneg(b0[k])) * __builtin_amdgcn_rcpf(1.0f + eneg(a0[k]));
                                                  acc[ai][bj][m][1][k] *= (1.0f + eneg(b1[k])) * __builtin_amdgcn_rcpf(1.0f + eneg(a1[k])); } } }
        }
    }
    __device__ __forceinline__ void operator()(const f32x4 (&acc)[2][2][4][2], const Unit& u, int wr, int wc, int fr, int fq) const {
        const int cb = u.pn * 4 + wc, col0 = cb * 64 + 8 * fq;
        const PieceOut po(scr, O, tm_block(u.pm, cb, 16), wr, wc, fr, fq);
        const PieceIn pb(scr, Z, tm_block(u.pm, gb_ct + cb, znct), wr, wc, fr, fq);
        f32x4 bb[2][2];
#pragma unroll
        for (int bj = 0; bj < 2; ++bj) { bb[bj][0] = *(const f32x4*)(bg + 1024 + col0 + bj * 32); bb[bj][1] = *(const f32x4*)(bg + 1024 + col0 + bj * 32 + 4); }
        u32x4 rb[2][4][2];
#pragma unroll
        for (int ai = 0; ai < 2; ++ai)
#pragma unroll
            for (int m = 0; m < 4; ++m) pb.fetch(ai, m, rb[ai][m][0], rb[ai][m][1]);
        asm volatile("" ::: "memory");
#pragma unroll
        for (int ai = 0; ai < 2; ++ai)
#pragma unroll
            for (int m = 0; m < 4; ++m) {
                pb.stage(rb[ai][m][0], rb[ai][m][1]); const u32x4 gb0 = pb.get(0), gb1 = pb.get(1);
                asm volatile("" ::: "memory");
#pragma unroll
                for (int bj = 0; bj < 2; ++bj) { const u32x4 gb = bj ? gb1 : gb0;
                    const f32x4 b0 = UNPK0(gb) + bb[bj][0], b1 = UNPK1(gb) + bb[bj][1];
                    f32x4 v0 = acc[ai][bj][m][0], v1 = acc[ai][bj][m][1];
#pragma unroll
                    for (int k = 0; k < 4; ++k) { v0[k] *= __builtin_amdgcn_rcpf(1.0f + eneg(b0[k])); v1[k] *= __builtin_amdgcn_rcpf(1.0f + eneg(b1[k])); }
                    po.put(bj, pack8(v0, v1)); }
                po.flush<false>(ai, m);
                asm volatile("" ::: "memory"); }
    }
};
struct EpiRes1 {
    static constexpr bool PERM = true, AFTER_DRAIN = false, HAS_MID = false, HAS_PRE = false;
    const float* x; bf16_t* X1; float* ss; PG8_LAS unsigned char* scr;
    __device__ __forceinline__ void operator()(const f32x4 (&acc)[2][2][4][2], const Unit& u, int wr, int wc, int fr, int fq) const {
        const int row0 = u.pm * BM + wr * 64 + fr, col0 = u.pn * BM + wc * 64 + 8 * fq;
        const PieceOut po(scr, X1, tm_block(u.pm, u.pn * 4 + wc, 16), wr, wc, fr, fq);
#pragma unroll
        for (int ai = 0; ai < 2; ++ai) {
            f32x4 xv[4][2][2];
#pragma unroll
            for (int m = 0; m < 4; ++m) { const float* xp = x + (size_t)(row0 + ai * HALF + m * 16) * 1024 + col0;
#pragma unroll
                for (int bj = 0; bj < 2; ++bj) { xv[m][bj][0] = *(const f32x4*)(xp + bj * 32); xv[m][bj][1] = *(const f32x4*)(xp + bj * 32 + 4); } }
            asm volatile("" ::: "memory");
#pragma unroll
            for (int m = 0; m < 4; ++m) { const int row = row0 + ai * HALF + m * 16; float sq = 0.f;
#pragma unroll
                for (int bj = 0; bj < 2; ++bj) { const f32x4 o0 = xv[m][bj][0] + acc[ai][bj][m][0], o1 = xv[m][bj][1] + acc[ai][bj][m][1];
                    sq += ((o0[0] * o0[0] + o0[1] * o0[1]) + (o0[2] * o0[2] + o0[3] * o0[3])) + ((o1[0] * o1[0] + o1[1] * o1[1]) + (o1[2] * o1[2] + o1[3] * o1[3]));
                    po.put(bj, pack8(o0, o1)); }
                po.flush<false>(ai, m);
                sq += __shfl_xor(sq, 16); sq += __shfl_xor(sq, 32);
                if (fq == 0) atomicAdd(ss + row, sq); }
        }
    }
};
struct EpiRes2 {
    static constexpr bool PERM = true, AFTER_DRAIN = false, HAS_MID = false, HAS_PRE = false;
    const bf16_t* X1; bf16_t* X2; float* ss; PG8_LAS unsigned char* scr;
    __device__ __forceinline__ void operator()(const f32x4 (&acc)[2][2][4][2], const Unit& u, int wr, int wc, int fr, int fq) const {
        const int row0 = u.pm * BM + wr * 64 + fr;
        const size_t blk = tm_block(u.pm, u.pn * 4 + wc, 16);
        const PieceIn pi(scr, X1, blk, wr, wc, fr, fq); const PieceOut po(scr, X2, blk, wr, wc, fr, fq);
        u32x4 rx[2][4][2];
#pragma unroll
        for (int ai = 0; ai < 2; ++ai)
#pragma unroll
            for (int m = 0; m < 4; ++m) pi.fetch(ai, m, rx[ai][m][0], rx[ai][m][1]);
        asm volatile("" ::: "memory");
#pragma unroll
        for (int ai = 0; ai < 2; ++ai)
#pragma unroll
            for (int m = 0; m < 4; ++m) { const int row = row0 + ai * HALF + m * 16; float sq = 0.f;
                pi.stage(rx[ai][m][0], rx[ai][m][1]); const u32x4 x0 = pi.get(0), x1 = pi.get(1);
                asm volatile("" ::: "memory");
#pragma unroll
                for (int bj = 0; bj < 2; ++bj) { const u32x4 z4 = bj ? x1 : x0;
                    const f32x4 o0 = UNPK0(z4) + acc[ai][bj][m][0], o1 = UNPK1(z4) + acc[ai][bj][m][1];
                    sq += ((o0[0] * o0[0] + o0[1] * o0[1]) + (o0[2] * o0[2] + o0[3] * o0[3])) + ((o1[0] * o1[0] + o1[1] * o1[1]) + (o1[2] * o1[2] + o1[3] * o1[3]));
                    po.put(bj, pack8(o0, o1)); }
                po.flush<false>(ai, m);
                asm volatile("" ::: "memory");
                sq += __shfl_xor(sq, 16); sq += __shfl_xor(sq, 32);
                if (fq == 0) atomicAdd(ss + row, sq); }
    }
};
struct EpiResNorm {
    static constexpr bool PERM = true, AFTER_DRAIN = false, HAS_MID = false, HAS_PRE = false;
    const bf16_t* X1; float* out; const float* gw; float* ss; unsigned* cnt; float eps; PG8_LAS unsigned char* scr;
    __device__ __forceinline__ void operator()(f32x4 (&acc)[2][2][4][2], const Unit& u, int wr, int wc, int fr, int fq) const {
        const int lane = fq * 16 + fr, row0 = u.pm * BM + wr * 64 + fr;
        const PieceIn pi(scr, X1, tm_block(u.pm, u.pn * 4 + wc, 16), wr, wc, fr, fq);
        u32x4 rx[2][4][2];
#pragma unroll
        for (int ai = 0; ai < 2; ++ai)
#pragma unroll
            for (int m = 0; m < 4; ++m) pi.fetch(ai, m, rx[ai][m][0], rx[ai][m][1]);
        asm volatile("" ::: "memory");
#pragma unroll
        for (int ai = 0; ai < 2; ++ai)
#pragma unroll
            for (int m = 0; m < 4; ++m) { const int row = row0 + ai * HALF + m * 16; float sq = 0.f;
                pi.stage(rx[ai][m][0], rx[ai][m][1]); const u32x4 x0 = pi.get(0), x1 = pi.get(1);
                asm volatile("" ::: "memory");
#pragma unroll
                for (int bj = 0; bj < 2; ++bj) { const u32x4 z4 = bj ? x1 : x0;
                    const f32x4 o0 = UNPK0(z4) + acc[ai][bj][m][0], o1 = UNPK1(z4) + acc[ai][bj][m][1];
                    acc[ai][bj][m][0] = o0; acc[ai][bj][m][1] = o1;
                    sq += ((o0[0] * o0[0] + o0[1] * o0[1]) + (o0[2] * o0[2] + o0[3] * o0[3])) + ((o1[0] * o1[0] + o1[1] * o1[1]) + (o1[2] * o1[2] + o1[3] * o1[3])); }
                sq += __shfl_xor(sq, 16); sq += __shfl_xor(sq, 32);
                if (fq == 0) atomicAdd(ss + row, sq); }
        asm volatile("s_waitcnt vmcnt(0)" ::: "memory");
        unsigned* c = cnt + 16 * u.pm;
        if (lane == 0) __hip_atomic_fetch_add(c, 1u, __ATOMIC_RELAXED, __HIP_MEMORY_SCOPE_AGENT);
        if (wr == 0 && wc == 0) { while (__hip_atomic_load(c, __ATOMIC_RELAXED, __HIP_MEMORY_SCOPE_AGENT) < 32u) __builtin_amdgcn_s_sleep(4); }
        asm volatile("s_waitcnt vmcnt(0) lgkmcnt(0)" ::: "memory"); __builtin_amdgcn_s_barrier(); asm volatile("" ::: "memory");
        float rs[2][4];
#pragma unroll
        for (int ai = 0; ai < 2; ++ai)
#pragma unroll
            for (int m = 0; m < 4; ++m) rs[ai][m] = __hip_atomic_load(ss + row0 + ai * HALF + m * 16, __ATOMIC_RELAXED, __HIP_MEMORY_SCOPE_AGENT);
        PG8_LAS unsigned char* my = scr + (wr * 4 + wc) * PG8_SCR_WAVE;
        PG8_LAS unsigned char* gp = my + fr * PG8_SCR_STRIDE + fq * 32;
        const PG8_LAS unsigned char* sp = my + (lane >> 3) * PG8_SCR_STRIDE + (lane & 7) * 16;
        float* ob = out + (size_t)(u.pm * BM + wr * 64 + (lane >> 3)) * 1024 + u.pn * BM + wc * 64 + (lane & 7) * 4;
        const int col0 = u.pn * BM + wc * 64 + 8 * fq;
#pragma unroll
        for (int bj = 0; bj < 2; ++bj) { const f32x4 g0 = *(const f32x4*)(gw + col0 + bj * 32), g1 = *(const f32x4*)(gw + col0 + bj * 32 + 4);
#pragma unroll
            for (int ai = 0; ai < 2; ++ai)
#pragma unroll
                for (int m = 0; m < 4; ++m) { const float r = __builtin_amdgcn_rsqf(rs[ai][m] * (1.0f / 1024.0f) + eps);
                    *(PG8_LAS f32x4*)gp = acc[ai][bj][m][0] * r * g0; *(PG8_LAS f32x4*)(gp + 16) = acc[ai][bj][m][1] * r * g1;
                    const f32x4 v0 = *(const PG8_LAS f32x4*)sp, v1 = *(const PG8_LAS f32x4*)(sp + 8 * PG8_SCR_STRIDE);
                    float* op = ob + (size_t)(ai * HALF + m * 16) * 1024 + bj * 32;
                    __builtin_nontemporal_store(v0, (f32x4*)op); __builtin_nontemporal_store(v1, (f32x4*)(op + 8 * 1024));
                    asm volatile("" ::: "memory"); } }
    }
};
struct EpiUp {
    static constexpr bool PERM = true, AFTER_DRAIN = false, HAS_MID = false, HAS_PRE = true;
    bf16_t* O; const float* ss; float eps; PG8_LAS unsigned char* scr;
    __device__ __forceinline__ void pre(float (&st)[8], const Unit& u, int wr, int wc, int fr, int fq) const {
        const float* sp = ss + u.pm * BM + wr * 64 + fr;
#pragma unroll
        for (int i = 0; i < 8; ++i) st[i] = sp[(i >> 2) * HALF + (i & 3) * 16];
    }
    __device__ __forceinline__ void post(const f32x4 (&acc)[2][2][4][2], const float (&st)[8], const Unit& u, int wr, int wc, int fr, int fq) const {
        const PieceOut po(scr, O, tm_block(u.pm, u.pn * 4 + wc, 64), wr, wc, fr, fq);
#pragma unroll
        for (int ai = 0; ai < 2; ++ai)
#pragma unroll
            for (int m = 0; m < 4; ++m) { const float rs = __builtin_amdgcn_rsqf(st[ai * 4 + m] * (1.0f / 1024.0f) + eps);
#pragma unroll
                for (int bj = 0; bj < 2; ++bj) { f32x4 v0 = acc[ai][bj][m][0] * rs, v1 = acc[ai][bj][m][1] * rs;
#pragma unroll
                    for (int k = 0; k < 4; ++k) { const float a = fmaxf(v0[k], 0.f), b = fmaxf(v1[k], 0.f); v0[k] = a * a; v1[k] = b * b; }
                    po.put(bj, pack8(v0, v1)); }
                po.flush<true>(ai, m); }
    }
};
template <class Epi, class Sched, bool ALIGN_EPI = false, bool SP2 = false>
__device__ __forceinline__ void gemm_phase(PG8_LAS unsigned char* lds, const Gemm g, const Sched& S, const Epi& E) {
    const int tid = threadIdx.x, wid = __builtin_amdgcn_readfirstlane(tid >> 6), lane = tid & 63, wr = wid >> 2, wc = wid & 3, fr = lane & 15, fq = lane >> 4;
    const int K = g.K, nt = K / BK;
    unsigned voffA[2], voffB[2];
#pragma unroll
    for (int i = 0; i < 2; ++i) { int R, C; stage_rc(tid * 16 + i * 8192, R, C); const int Rb = Epi::PERM ? (64 * (R >> 5) + perm32(R & 31)) : R;
        voffA[i] = (unsigned)(R * 64 + C) * 2u; voffB[i] = (unsigned)(Rb * 64 + C) * 2u; }
    const size_t kstep = (size_t)32768;
    const size_t hstep = (size_t)HALF * 128;
    const size_t tstep = (size_t)256 * K * 2; const size_t hstepB = Epi::PERM ? (size_t)32 * 128 : hstep;
    const unsigned ldsw = (unsigned)wid * 1024u;
    const int aoff = lds_byte(wr * 64 + fr, fq * 8), boff = lds_byte(wc * 32 + fr, fq * 8);
#define PG8_SA(b, h) (((b) * 2 + (h)) * HTB)
#define PG8_SB(b, h) ((4 + (b) * 2 + (h)) * HTB)
#define PG8_STAGE(bufoff, gbase, voff) do { _Pragma("unroll") for (int _i = 0; _i < 2; ++_i) \
        __builtin_amdgcn_global_load_lds((const unsigned*)((const char*)(gbase) + (voff)[_i]), (PG8_LAS unsigned*)(lds + (bufoff) + ldsw + _i * 8192), 16, 0, 0); } while (0)
#define PG8_LDA(dst, b, h) do { _Pragma("unroll") for (int m = 0; m < 4; ++m) _Pragma("unroll") for (int k = 0; k < 2; ++k) dst[m][k] = *(const PG8_LAS bf16x8*)(lds + PG8_SA(b, h) + aoff + m * 2048 + k * 1024); } while (0)
#define PG8_LDB(dst, b, h) do { _Pragma("unroll") for (int n = 0; n < 2; ++n) _Pragma("unroll") for (int k = 0; k < 2; ++k) dst[n][k] = *(const PG8_LAS bf16x8*)(lds + PG8_SB(b, h) + boff + n * 2048 + k * 1024); } while (0)
#define PG8_MMA(ai, bj, At, Bt) do { __builtin_amdgcn_s_setprio(1); _Pragma("unroll") for (int m = 0; m < 4; ++m) _Pragma("unroll") for (int n = 0; n < 2; ++n) _Pragma("unroll") for (int k = 0; k < 2; ++k) \
        acc[ai][bj][m][n] = __builtin_amdgcn_mfma_f32_16x16x32_bf16(Bt[n][k], At[m][k], acc[ai][bj][m][n], 0, 0, 0); __builtin_amdgcn_s_setprio(0); } while (0)
#define PG8_WAIT_V(n) asm volatile("s_waitcnt vmcnt(" #n ")" ::: "memory")
#define PG8_WAIT_L(n) asm volatile("s_waitcnt lgkmcnt(" #n ")" ::: "memory")
#define PG8_BAR __builtin_amdgcn_s_barrier()
#define PG8_SCHED __builtin_amdgcn_sched_barrier(0)
    Unit cur, nxt; int ui = 0;
    if (!S.next(0, cur)) return;
    f32x4 acc[2][2][4][2];
#pragma unroll
    for (int a = 0; a < 2; ++a)
#pragma unroll
        for (int b = 0; b < 2; ++b)
#pragma unroll
            for (int m = 0; m < 4; ++m)
#pragma unroll
                for (int n = 0; n < 2; ++n) acc[a][b][m][n] = (f32x4){0.f, 0.f, 0.f, 0.f};
    bf16x8 At[4][2], B0[2][2], B1[2][2];
    const char* cA = (const char*)g.A + (size_t)cur.pm * tstep; const char* cB = (const char*)g.Bt + (size_t)cur.pn * tstep;
    S.a_ready(cur);
    float pre_st[8];
    if constexpr (Epi::HAS_PRE) E.pre(pre_st, cur, wr, wc, fr, fq);
    if constexpr (SP2) {
        PG8_STAGE(PG8_SB(0, 0), cB, voffB); PG8_STAGE(PG8_SB(0, 1), cB + hstepB, voffB); PG8_STAGE(PG8_SA(0, 0), cA, voffA); PG8_STAGE(PG8_SA(0, 1), cA + hstep, voffA);
        if (wr == 1) PG8_BAR;
        PG8_WAIT_V(2); PG8_BAR;
        PG8_STAGE(PG8_SB(1, 0), cB + kstep, voffB); PG8_STAGE(PG8_SA(1, 0), cA + kstep, voffA); PG8_STAGE(PG8_SB(1, 1), cB + hstepB + kstep, voffB);
        PG8_WAIT_V(6); PG8_BAR;
    } else {
        PG8_STAGE(PG8_SB(0, 0), cB, voffB); PG8_STAGE(PG8_SA(0, 0), cA, voffA); PG8_STAGE(PG8_SB(0, 1), cB + hstepB, voffB); PG8_STAGE(PG8_SA(0, 1), cA + hstep, voffA);
        if (wr == 1) PG8_BAR;
        PG8_WAIT_V(4); PG8_BAR;
        PG8_STAGE(PG8_SB(1, 0), cB + kstep, voffB); PG8_STAGE(PG8_SA(1, 0), cA + kstep, voffA); PG8_STAGE(PG8_SB(1, 1), cB + hstepB + kstep, voffB);
        PG8_WAIT_V(6); PG8_BAR;
    }
    for (;;) {
        const bool has_next = S.next(ui + 1, nxt);
        const char* nA = has_next ? (const char*)g.A + (size_t)nxt.pm * tstep : cA; const char* nB = has_next ? (const char*)g.Bt + (size_t)nxt.pn * tstep : cB;
        for (int t = 0; t < nt; t += 2) {
            if constexpr (Epi::HAS_MID) { if (t == (nt >> 1)) E.mid(acc, cur, wr, wc, fr, fq); }
            const bool last = (t == nt - 2);
            const char* a1 = cA + (size_t)(t + 1) * kstep;
            const char* a2 = last ? nA : cA + (size_t)(t + 2) * kstep; const char* b2 = last ? nB : cB + (size_t)(t + 2) * kstep;
            const char* a3 = a2 + kstep; const char* b3 = b2 + kstep;
            if (last && has_next) S.a_ready(nxt);
            if constexpr (SP2) {
            PG8_LDB(B0, 0, 0); PG8_LDB(B1, 0, 1); PG8_SCHED; PG8_LDA(At, 0, 0); PG8_STAGE(PG8_SA(1, 1), a1 + hstep, voffA);
            PG8_WAIT_V(8); PG8_WAIT_L(0); PG8_BAR; PG8_MMA(0, 0, At, B0); PG8_MMA(0, 1, At, B1); PG8_BAR; PG8_SCHED;
            PG8_LDA(At, 0, 1); PG8_STAGE(PG8_SB(0, 0), b2, voffB); PG8_STAGE(PG8_SB(0, 1), b2 + hstepB, voffB); PG8_STAGE(PG8_SA(0, 0), a2, voffA);
            PG8_WAIT_V(8); PG8_WAIT_L(0); PG8_BAR; PG8_MMA(1, 0, At, B0); PG8_MMA(1, 1, At, B1); PG8_BAR; PG8_SCHED;
            PG8_LDB(B0, 1, 0); PG8_LDB(B1, 1, 1); PG8_SCHED; PG8_LDA(At, 1, 0); PG8_STAGE(PG8_SA(0, 1), a2 + hstep, voffA);
            PG8_WAIT_V(8); PG8_WAIT_L(0); PG8_BAR; PG8_MMA(0, 0, At, B0); PG8_MMA(0, 1, At, B1); PG8_BAR; PG8_SCHED;
            PG8_LDA(At, 1, 1); PG8_STAGE(PG8_SB(1, 0), b3, voffB); PG8_STAGE(PG8_SB(1, 1), b3 + hstepB, voffB); PG8_STAGE(PG8_SA(1, 0), a3, voffA);
            PG8_WAIT_V(8); PG8_WAIT_L(0); PG8_BAR; PG8_MMA(1, 0, At, B0); PG8_MMA(1, 1, At, B1); PG8_BAR; PG8_SCHED;
            } else {
            PG8_LDB(B0, 0, 0); PG8_SCHED; PG8_LDA(At, 0, 0); PG8_STAGE(PG8_SA(1, 1), a1 + hstep, voffA);
            PG8_WAIT_L(8); PG8_BAR; PG8_WAIT_L(0); PG8_MMA(0, 0, At, B0); PG8_BAR; PG8_SCHED;
            PG8_LDB(B1, 0, 1); PG8_STAGE(PG8_SB(0, 0), b2, voffB);
            PG8_BAR; PG8_WAIT_L(0); PG8_MMA(0, 1, At, B1); PG8_BAR;
            PG8_LDA(At, 0, 1); PG8_STAGE(PG8_SA(0, 0), a2, voffA);
            PG8_BAR; PG8_WAIT_L(0); PG8_MMA(1, 0, At, B0); PG8_BAR; PG8_SCHED;
            PG8_STAGE(PG8_SB(0, 1), b2 + hstepB, voffB);
            PG8_WAIT_V(6); PG8_BAR; PG8_MMA(1, 1, At, B1); PG8_BAR;
            PG8_LDB(B0, 1, 0); PG8_SCHED; PG8_LDA(At, 1, 0); PG8_STAGE(PG8_SA(0, 1), a2 + hstep, voffA);
            PG8_WAIT_L(8); PG8_BAR; PG8_WAIT_L(0); PG8_MMA(0, 0, At, B0); PG8_BAR; PG8_SCHED;
            PG8_LDB(B1, 1, 1); PG8_STAGE(PG8_SB(1, 0), b3, voffB);
            PG8_BAR; PG8_WAIT_L(0); PG8_MMA(0, 1, At, B1); PG8_BAR;
            PG8_LDA(At, 1, 1); PG8_STAGE(PG8_SA(1, 0), a3, voffA);
            PG8_BAR; PG8_WAIT_L(0); PG8_MMA(1, 0, At, B0); PG8_BAR; PG8_SCHED;
            PG8_STAGE(PG8_SB(1, 1), b3 + hstepB, voffB);
            PG8_WAIT_V(6); PG8_BAR; PG8_MMA(1, 1, At, B1); PG8_BAR;
            }
        }
        if constexpr (ALIGN_EPI) { if (wr == 0) PG8_BAR; }
        if constexpr (!Epi::AFTER_DRAIN) { if constexpr (Epi::HAS_PRE) { E.post(acc, pre_st, cur, wr, wc, fr, fq); if (has_next) E.pre(pre_st, nxt, wr, wc, fr, fq); } else E(acc, cur, wr, wc, fr, fq); S.done(cur); }
        if (!has_next) break;
#pragma unroll
        for (int a = 0; a < 2; ++a)
#pragma unroll
            for (int b = 0; b < 2; ++b)
#pragma unroll
                for (int m = 0; m < 4; ++m)
#pragma unroll
                    for (int n = 0; n < 2; ++n) acc[a][b][m][n] = (f32x4){0.f, 0.f, 0.f, 0.f};
        cur = nxt; cA = nA; cB = nB; ++ui;
        if constexpr (ALIGN_EPI) { if (wr == 1) PG8_BAR; }
    }
    PG8_WAIT_V(0);
    if constexpr (!ALIGN_EPI) { if (wr == 0) PG8_BAR; }
    PG8_BAR;
    if constexpr (Epi::AFTER_DRAIN) { E.fused(acc, cur, wr, wc, fr, fq, lds, wid, lane); S.done(cur); }
#undef PG8_SA
#undef PG8_SB
#undef PG8_STAGE
#undef PG8_LDA
#undef PG8_LDB
#undef PG8_MMA
#undef PG8_WAIT_V
#undef PG8_WAIT_L
#undef PG8_BAR
#undef PG8_SCHED
}
}
#ifndef PG8_SP2
#define PG8_SP2 true
#endif
#ifndef PG8_ALIGN
#define PG8_ALIGN true
#endif
#ifndef MK_MULTI
#define MK_MULTI 0
#endif

constexpr int BATCH = 8, SEQ = 8192, DM = 1024, FF = 4096, M = BATCH * SEQ;
constexpr int ZLD = 4352;
constexpr int Z_QA = 0, Z_KA = 512, Z_VA = 640, Z_QB = 768, Z_KB = 1280, Z_VB = 1792, Z_GA = 2304, Z_GB = 3328;
constexpr float EPS = 1e-6f, LOG2E = 1.4426950408889634f;
constexpr int NWAVES = 8, NTHREADS = 512;
constexpr size_t MiB = 1u << 20;
constexpr size_t WS_SS1 = 0, WS_SS2 = 256 * 1024, WS_CNT = 512 * 1024, WS_BAR = 768 * 1024, WS_BAR_BYTES = 16384;
constexpr size_t WS_WIN = 1 * MiB;
constexpr size_t WS_WPA = 10 * MiB, WS_WPB = 11 * MiB;
constexpr size_t WS_WOUT = 12 * MiB;
constexpr size_t WS_WUP = 14 * MiB;
constexpr size_t WS_WDN = 22 * MiB;
constexpr size_t WS_XN = 32 * MiB;
constexpr size_t WS_YA = 160 * MiB, WS_YB = 224 * MiB;
constexpr size_t WS_X2 = 160 * MiB;
constexpr size_t WS_MG = 288 * MiB;
constexpr size_t WS_Z = 416 * MiB;
constexpr size_t WS_END = 960 * MiB;
constexpr int LDS_BYTES = 155648;
#define LAS __attribute__((address_space(3)))
typedef unsigned short bf16;
typedef unsigned v4u __attribute__((ext_vector_type(4)));
typedef unsigned v2u __attribute__((ext_vector_type(2)));
typedef float f32x4 __attribute__((ext_vector_type(4)));
typedef short bf16x8 __attribute__((ext_vector_type(8)));
typedef short s16x4 __attribute__((ext_vector_type(4)));
#define LDS_WAIT() asm volatile("s_waitcnt lgkmcnt(0)" ::: "memory")
__device__ __forceinline__ unsigned f2bf(float f) { unsigned u = __builtin_bit_cast(unsigned, f); return (u + 0x7fffu + ((u >> 16) & 1u)) >> 16; }
__device__ __forceinline__ unsigned pk2(float lo, float hi) { return pg8::cvt_pk_bf16(lo, hi); }
__device__ __forceinline__ float wave_sum(float v) {
#pragma unroll
    for (int o = 1; o < 64; o <<= 1) v += __shfl_xor(v, o);
    return v;
}
__device__ __forceinline__ size_t tmo(int row, int ct, int nct) { return ((size_t)(row >> 8) * nct + ct) * 32768 + (size_t)(row & 255) * 128; }
__device__ __forceinline__ void p0_transpose_item(const float* W, int K, int N, bf16* WT, LAS float* scr, int item, int lane, const float* gk = nullptr, int ldw = 0, int koff = 0) {
    if (ldw == 0) ldw = K;
    const int nblk = N / 32, kb = item / nblk, nb = item % nblk, k0 = 64 * kb, n0 = 32 * nb;
#pragma unroll 8
    for (int i = 0; i < 32; ++i) { const int kk = 2 * i + (lane >> 5); scr[kk * 33 + (lane & 31)] = W[(size_t)(k0 + kk) * N + n0 + (lane & 31)] * (gk ? gk[k0 + kk] : 1.0f); }
    LDS_WAIT(); asm volatile("" ::: "memory");
    const int c = lane & 7;
#pragma unroll
    for (int j = 0; j < 4; ++j) { const int n = (lane >> 3) + 8 * j; const LAS float* s = scr + (8 * c) * 33 + n;
        v4u o; o.x = pk2(s[0 * 33], s[1 * 33]); o.y = pk2(s[2 * 33], s[3 * 33]); o.z = pk2(s[4 * 33], s[5 * 33]); o.w = pk2(s[6 * 33], s[7 * 33]);
        *(v4u*)((unsigned char*)WT + tmo(n0 + n, (koff + k0) >> 6, ldw >> 6) + 16 * c) = o; }
    LDS_WAIT(); asm volatile("" ::: "memory");
}
__device__ __forceinline__ void rms_row_to_bf16(const float* xrow, const float* g, bf16* orow, int lane) {
    const f32x4* xr = (const f32x4*)xrow + lane; const f32x4* gr = (const f32x4*)g + lane;
    f32x4 v[4]; float s = 0.f;
#pragma unroll
    for (int j = 0; j < 4; ++j) { v[j] = xr[64 * j]; s += (v[j].x * v[j].x + v[j].y * v[j].y) + (v[j].z * v[j].z + v[j].w * v[j].w); }
    const float rstd = 1.0f / sqrtf(wave_sum(s) * (1.f / DM) + EPS);
    unsigned long long* o8 = (unsigned long long*)orow + lane;
#pragma unroll
    for (int j = 0; j < 4; ++j) { const f32x4 gg = gr[64 * j]; const f32x4 t = v[j] * rstd * gg;
        o8[64 * j] = (unsigned long long)pk2(t.x, t.y) | ((unsigned long long)pk2(t.z, t.w) << 32); }
}
__device__ __forceinline__ int swz(int row, int chunk) { return row * 128 + ((chunk ^ (row & 7)) << 4); }
__device__ __forceinline__ s16x4 vtr(const LAS unsigned char* p) { return __builtin_bit_cast(s16x4, __builtin_amdgcn_ds_read_tr16_b64_v4i16((LAS s16x4*)p)); }
#define MFMA16(a, b, c) __builtin_amdgcn_mfma_f32_16x16x32_bf16((a), (b), (c), 0, 0, 0)

__device__ __forceinline__ void qk_step(const LAS unsigned char* Kl, int rb0, int rb1, int lq, int g, bf16x8 qf0, bf16x8 qf1, f32x4& S0, f32x4& S1) {
    const bf16x8 k00 = *(const LAS bf16x8*)(Kl + swz(rb0 + lq, g)), k01 = *(const LAS bf16x8*)(Kl + swz(rb0 + lq, 4 + g));
    const bf16x8 k10 = *(const LAS bf16x8*)(Kl + swz(rb1 + lq, g)), k11 = *(const LAS bf16x8*)(Kl + swz(rb1 + lq, 4 + g));
    const f32x4 z = {0.f, 0.f, 0.f, 0.f};
    S0 = MFMA16(k00, qf0, z); S0 = MFMA16(k01, qf1, S0);
    S1 = MFMA16(k10, qf0, z); S1 = MFMA16(k11, qf1, S1);
}
__device__ __forceinline__ void pv_step(const LAS unsigned char* Vl, int rb0, int rb1, int lane, int g, const f32x4& P0, const f32x4& P1, f32x4 (&O)[4]) {
    v4u pw; pw.x = pk2(P0[0], P0[1]); pw.y = pk2(P0[2], P0[3]); pw.z = pk2(P1[0], P1[1]); pw.w = pk2(P1[2], P1[3]);
    const bf16x8 pb = __builtin_bit_cast(bf16x8, pw);
    const int i = lane & 15, rq = i >> 2, p = i & 3;
    const int r0 = rb0 + 4 * g + rq, r1 = rb1 + 4 * g + rq;
#pragma unroll
    for (int db = 0; db < 4; ++db) {
        const s16x4 lo = vtr(Vl + swz(r0, 2 * db + (p >> 1)) + 8 * (p & 1));
        const s16x4 hi = vtr(Vl + swz(r1, 2 * db + (p >> 1)) + 8 * (p & 1));
        const bf16x8 vt = (bf16x8){lo[0], lo[1], lo[2], lo[3], hi[0], hi[1], hi[2], hi[3]};
        O[db] = MFMA16(vt, pb, O[db]);
    }
}
__device__ __forceinline__ void qk_at(const LAS unsigned char* kp0, const LAS unsigned char* kp1, int off, bf16x8 qf0, bf16x8 qf1, f32x4& S0, f32x4& S1) {
    const bf16x8 k00 = *(const LAS bf16x8*)(kp0 + off), k01 = *(const LAS bf16x8*)(kp1 + off);
    const bf16x8 k10 = *(const LAS bf16x8*)(kp0 + off + 2048), k11 = *(const LAS bf16x8*)(kp1 + off + 2048);
    const f32x4 z = {0.f, 0.f, 0.f, 0.f};
    S0 = MFMA16(k00, qf0, z); S0 = MFMA16(k01, qf1, S0);
    S1 = MFMA16(k10, qf0, z); S1 = MFMA16(k11, qf1, S1);
}
__device__ __forceinline__ void pv_at(const LAS unsigned char* const (&vp)[4], int off, const f32x4& P0, const f32x4& P1, f32x4 (&O)[4]) {
    v4u pw; pw.x = pk2(P0[0], P0[1]); pw.y = pk2(P0[2], P0[3]); pw.z = pk2(P1[0], P1[1]); pw.w = pk2(P1[2], P1[3]);
    const bf16x8 pb = __builtin_bit_cast(bf16x8, pw);
#pragma unroll
    for (int db = 0; db < 4; ++db) {
        const s16x4 lo = vtr(vp[db] + off), hi = vtr(vp[db] + off + 2048);
        const bf16x8 vt = (bf16x8){lo[0], lo[1], lo[2], lo[3], hi[0], hi[1], hi[2], hi[3]};
        O[db] = MFMA16(vt, pb, O[db]);
    }
}
__device__ __forceinline__ float xrow16_max(float x) {
    auto s = __builtin_amdgcn_permlane16_swap(__float_as_uint(x), __float_as_uint(x), false, false);
    x = fmaxf(__uint_as_float(s[0]), __uint_as_float(s[1]));
    auto t = __builtin_amdgcn_permlane32_swap(__float_as_uint(x), __float_as_uint(x), false, false);
    return fmaxf(__uint_as_float(t[0]), __uint_as_float(t[1]));
}
__device__ __forceinline__ float xrow16_sum(float x) {
    auto s = __builtin_amdgcn_permlane16_swap(__float_as_uint(x), __float_as_uint(x), false, false);
    x = __uint_as_float(s[0]) + __uint_as_float(s[1]);
    auto t = __builtin_amdgcn_permlane32_swap(__float_as_uint(x), __float_as_uint(x), false, false);
    return __uint_as_float(t[0]) + __uint_as_float(t[1]);
}
__device__ __forceinline__ void softmax_step(f32x4& s0, f32x4& s1, float& m, float& l, f32x4 (&O)[4]) {
    float t = fmaxf(fmaxf(fmaxf(s0[0], s0[1]), fmaxf(s0[2], s0[3])), fmaxf(fmaxf(s1[0], s1[1]), fmaxf(s1[2], s1[3])));
    t = xrow16_max(t);
    const float mn = fmaxf(m, t), alpha = __builtin_amdgcn_exp2f(m - mn);
    m = mn;
#pragma unroll
    for (int k = 0; k < 4; ++k) { s0[k] = __builtin_amdgcn_exp2f(s0[k] - mn); s1[k] = __builtin_amdgcn_exp2f(s1[k] - mn); }
    l = l * alpha + ((s0[0] + s0[1]) + (s0[2] + s0[3])) + ((s1[0] + s1[1]) + (s1[2] + s1[3]));
#pragma unroll
    for (int db = 0; db < 4; ++db) O[db] *= alpha;
}
__device__ __forceinline__ void store_o(bf16* yrow, int g, float l, const f32x4 (&O)[4]) {
    const float inv = 1.0f / xrow16_sum(l);
    unsigned wx[4], wy[4];
#pragma unroll
    for (int db = 0; db < 4; ++db) { wx[db] = pk2(O[db][0] * inv, O[db][1] * inv); wy[db] = pk2(O[db][2] * inv, O[db][3] * inv); }
#pragma unroll
    for (int p = 0; p < 2; ++p) {
        auto rx = __builtin_amdgcn_permlane16_swap(wx[2 * p], wx[2 * p + 1], false, false); wx[2 * p] = rx[0]; wx[2 * p + 1] = rx[1];
        auto ry = __builtin_amdgcn_permlane16_swap(wy[2 * p], wy[2 * p + 1], false, false); wy[2 * p] = ry[0]; wy[2 * p + 1] = ry[1]; }
#pragma unroll
    for (int p = 0; p < 2; ++p) {
        auto rx = __builtin_amdgcn_permlane32_swap(wx[p], wx[p + 2], false, false); wx[p] = rx[0]; wx[p + 2] = rx[1];
        auto ry = __builtin_amdgcn_permlane32_swap(wy[p], wy[p + 2], false, false); wy[p] = ry[0]; wy[p + 2] = ry[1]; }
    v4u lo = {wx[0], wy[0], wx[1], wy[1]}, hi = {wx[2], wy[2], wx[3], wy[3]};
    *(v4u*)(yrow + 16 * g) = lo; *(v4u*)(yrow + 16 * g + 8) = hi;
}

constexpr int A_ROWS = 400, A_KOFF = 0, A_VOFF = A_ROWS * 128;
template <bool MASK> __device__ __forceinline__ void a_scores(f32x4& S0, f32x4& S1, float basef, float c1, float slope2, int krow0, int kstart) {
#pragma unroll
    for (int r = 0; r < 4; ++r) {
        const float d0 = fabsf(basef - (float)r), d1 = fabsf(basef - (float)(16 + r));
        const float v0 = S0[r] * c1 - slope2 * d0, v1 = S1[r] * c1 - slope2 * d1;
        if (MASK) { const int p0 = kstart + krow0 + r, p1 = p0 + 16;
            S0[r] = (d0 <= 128.f && p0 >= 0 && p0 < SEQ) ? v0 : -INFINITY; S1[r] = (d1 <= 128.f && p1 >= 0 && p1 < SEQ) ? v1 : -INFINITY; }
        else { S0[r] = v0; S1[r] = v1; }
    }
}
__device__ __forceinline__ void attn_a_prefetch(const bf16* Z, int unit, v4u (&kr)[7], v4u (&vr)[7]) {
    const int tid = threadIdx.x; const int ib = unit & 63, kvh = (unit >> 6) & 1, b = unit >> 7;
    const size_t tok0 = (size_t)b * SEQ; const int kstart = (ib - 1) * 128;
#pragma unroll
    for (int k = 0; k < 7; ++k) { const int it = tid + k * NTHREADS; const int row = it >> 3, ch = it & 7, pos = kstart + row;
        kr[k] = (v4u){0u, 0u, 0u, 0u}; vr[k] = (v4u){0u, 0u, 0u, 0u};
        if (it < A_ROWS * 8 && row < 384 && pos >= 0 && pos < SEQ) { const int t = (int)tok0 + pos; kr[k] = *(const v4u*)((const unsigned char*)Z + tmo(t, Z_KA / 64 + kvh, ZLD / 64) + ch * 16); vr[k] = *(const v4u*)((const unsigned char*)Z + tmo(t, Z_VA / 64 + kvh, ZLD / 64) + ch * 16); } }
}
__device__ __forceinline__ void attn_a_commit(LAS unsigned char* lds, const v4u (&kr)[7], const v4u (&vr)[7]) {
    const int tid = threadIdx.x; LAS unsigned char* Kl = lds + A_KOFF; LAS unsigned char* Vl = lds + A_VOFF;
#pragma unroll
    for (int k = 0; k < 7; ++k) { const int it = tid + k * NTHREADS; const int row = it >> 3, ch = it & 7;
        if (it < A_ROWS * 8) { *(LAS v4u*)(Kl + swz(row, ch)) = kr[k]; *(LAS v4u*)(Vl + swz(row, ch)) = vr[k]; } }
}
__device__ __forceinline__ void attn_a_unit(LAS unsigned char* lds, const bf16* Z, bf16* Y, const float* sink, int unit) {
    const int tid = threadIdx.x, lane = tid & 63, wid = tid >> 6, lq = lane & 15, g = lane >> 4;
    const int ib = unit & 63, kvh = (unit >> 6) & 1, b = unit >> 7;
    const size_t tok0 = (size_t)b * SEQ; const int kstart = (ib - 1) * 128;
    LAS unsigned char* Kl = lds + A_KOFF; LAS unsigned char* Vl = lds + A_VOFF;
    const int hq = kvh * 4 + (wid >> 1);
    const float slope2 = __builtin_amdgcn_exp2f(-(float)(hq + 1)) * LOG2E, sink2 = sink[hq] * LOG2E, c1 = 0.125f * LOG2E;
    const bool edge = (ib == 0) || (ib == 63);
    for (int bp = 0; bp < 2; ++bp) {
        const int qoffA = (wid & 1) * 64 + bp * 32, qoffB = qoffA + 16;
        const size_t qtokA = tok0 + ib * 128 + qoffA + lq, qtokB = qtokA + 16;
        const unsigned char* qpA = (const unsigned char*)Z + tmo((int)qtokA, Z_QA / 64 + hq, ZLD / 64) + 16 * g; const unsigned char* qpB = qpA + 16 * 128;
        const bf16x8 qA0 = *(const bf16x8*)qpA, qA1 = *(const bf16x8*)(qpA + 64), qB0 = *(const bf16x8*)qpB, qB1 = *(const bf16x8*)(qpB + 64);
        float mA = sink2, lA = (g == 0) ? 1.0f : 0.0f, mB = sink2, lB = lA;
        f32x4 OA[4], OB[4];
#pragma unroll
        for (int d = 0; d < 4; ++d) { OA[d] = (f32x4){0.f, 0.f, 0.f, 0.f}; OB[d] = (f32x4){0.f, 0.f, 0.f, 0.f}; }
        if (edge) {
        for (int st = 0; st < 9; ++st) {
            const int rbA = qoffA + 32 * st, rbB = rbA + 16;
            f32x4 SA0, SA1, SB0, SB1;
            qk_step(Kl, rbA, rbA + 16, lq, g, qA0, qA1, SA0, SA1);
            qk_step(Kl, rbB, rbB + 16, lq, g, qB0, qB1, SB0, SB1);
            const float basef = (float)(128 + lq - 32 * st - 4 * g);
            a_scores<true>(SA0, SA1, basef, c1, slope2, rbA + 4 * g, kstart); a_scores<true>(SB0, SB1, basef, c1, slope2, rbB + 4 * g, kstart);
            softmax_step(SA0, SA1, mA, lA, OA);
            softmax_step(SB0, SB1, mB, lB, OB);
            pv_step(Vl, rbA, rbA + 16, lane, g, SA0, SA1, OA);
            pv_step(Vl, rbB, rbB + 16, lane, g, SB0, SB1, OB);
        }
        } else {
        const LAS unsigned char* kp0 = Kl + swz(qoffA + lq, g); const LAS unsigned char* kp1 = Kl + swz(qoffA + lq, 4 + g);
        const LAS unsigned char* vp[4];
        { const int i = lane & 15, rq4 = i >> 2, p = i & 3;
#pragma unroll
          for (int db = 0; db < 4; ++db) vp[db] = Vl + swz(qoffA + 4 * g + rq4, 2 * db + (p >> 1)) + 8 * (p & 1); }
        float basef = (float)(128 + lq - 4 * g);
#define A_STEP(MASKED, ST) do { f32x4 SA0, SA1, SB0, SB1; \
            qk_at(kp0, kp1, 0, qA0, qA1, SA0, SA1); qk_at(kp0, kp1, 2048, qB0, qB1, SB0, SB1); \
            if (MASKED) { const int rbA_ = qoffA + 32 * (ST); a_scores<true>(SA0, SA1, basef, c1, slope2, rbA_ + 4 * g, kstart); a_scores<true>(SB0, SB1, basef, c1, slope2, rbA_ + 16 + 4 * g, kstart); } \
            else { a_scores<false>(SA0, SA1, basef, c1, slope2, 0, 0); a_scores<false>(SB0, SB1, basef, c1, slope2, 0, 0); } \
            softmax_step(SA0, SA1, mA, lA, OA); softmax_step(SB0, SB1, mB, lB, OB); \
            pv_at(vp, 0, SA0, SA1, OA); pv_at(vp, 2048, SB0, SB1, OB); \
            kp0 += 4096; kp1 += 4096; basef -= 32.f; _Pragma("unroll") for (int db_ = 0; db_ < 4; ++db_) vp[db_] += 4096; } while (0)
        A_STEP(true, 0);
        for (int st = 1; st < 8; ++st) A_STEP(false, st);
        A_STEP(true, 8);
#undef A_STEP
        }
        store_o((bf16*)((unsigned char*)Y + tmo((int)qtokA, hq, 16)), g, lA, OA);
        store_o((bf16*)((unsigned char*)Y + tmo((int)qtokB, hq, 16)), g, lB, OB);
    }
}
constexpr int B_ROWS = 9 * 64, B_KOFF = 0, B_VOFF = B_ROWS * 128, B_TOFF = 2 * B_ROWS * 128, B_TSIZE = 544;
static_assert(B_TOFF + B_TSIZE * 4 <= LDS_BYTES && A_VOFF + A_ROWS * 128 <= LDS_BYTES, "LDS map");
__device__ __forceinline__ int clampi(int v, int lo, int hi) { return v < lo ? lo : (v > hi ? hi : v); }
__device__ __forceinline__ void attn_b_prefetch(const bf16* Z, const float* rpb, int unit, v4u (&kr)[9], v4u (&vr)[9], float (&tr)[2]) {
    const int tid = threadIdx.x; const int rp = unit & 63, h = (unit >> 6) & 7, b = unit >> 9;
    const size_t tok0 = (size_t)b * SEQ; const int R0 = clampi(2 * rp - 4, 0, 120);
#pragma unroll
    for (int k = 0; k < 9; ++k) { const int it = tid + k * NTHREADS; const int row = it >> 3, ch = it & 7, gr = R0 + (row >> 6);
        kr[k] = (v4u){0u, 0u, 0u, 0u}; vr[k] = (v4u){0u, 0u, 0u, 0u};
        if (gr < 128) { const int t = (int)tok0 + gr * 64 + (row & 63); kr[k] = *(const v4u*)((const unsigned char*)Z + tmo(t, Z_KB / 64 + h, ZLD / 64) + ch * 16); vr[k] = *(const v4u*)((const unsigned char*)Z + tmo(t, Z_VB / 64 + h, ZLD / 64) + ch * 16); } }
#pragma unroll
    for (int k = 0; k < 2; ++k) { const int it = tid + k * NTHREADS, e = it - 16, dr = e >> 5, dc = e & 31;
        tr[k] = (it < B_TSIZE && e >= 0 && dr < 15 && dc < 31) ? rpb[h * 465 + dr * 31 + dc] * LOG2E : 0.f; }
}
__device__ __forceinline__ void attn_b_commit(LAS unsigned char* lds, const v4u (&kr)[9], const v4u (&vr)[9], const float (&tr)[2]) {
    const int tid = threadIdx.x; LAS unsigned char* Kl = lds + B_KOFF; LAS unsigned char* Vl = lds + B_VOFF; LAS float* T = (LAS float*)(lds + B_TOFF);
#pragma unroll
    for (int k = 0; k < 9; ++k) { const int it = tid + k * NTHREADS; const int row = it >> 3, ch = it & 7;
        *(LAS v4u*)(Kl + swz(row, ch)) = kr[k]; *(LAS v4u*)(Vl + swz(row, ch)) = vr[k]; }
#pragma unroll
    for (int k = 0; k < 2; ++k) { const int it = tid + k * NTHREADS; if (it < B_TSIZE) T[it] = tr[k]; }
}
__device__ __forceinline__ void attn_b_unit(LAS unsigned char* lds, const bf16* Z, bf16* Y, int unit) {
    const int tid = threadIdx.x, lane = tid & 63, wid = tid >> 6, lq = lane & 15, g = lane >> 4;
    const int rp = unit & 63, h = (unit >> 6) & 7, b = unit >> 9;
    const size_t tok0 = (size_t)b * SEQ;
    const int R0 = clampi(2 * rp - 4, 0, 120);
    LAS unsigned char* Kl = lds + B_KOFF; LAS unsigned char* Vl = lds + B_VOFF; LAS float* T = (LAS float*)(lds + B_TOFF);
    const int rq = 2 * rp + (wid >> 2), cb = wid & 3, c = 16 * cb + lq;
    const int r0q = clampi(rq - 4, 0, 120), kc0 = clampi(16 * cb - 8, 0, 32), cs = clampi(c - 8, 0, 48);
    const size_t qtok = tok0 + (size_t)rq * 64 + c;
    const unsigned char* qp = (const unsigned char*)Z + tmo((int)qtok, Z_QB / 64 + h, ZLD / 64) + 16 * g;
    const bf16x8 qf0 = *(const bf16x8*)qp, qf1 = *(const bf16x8*)(qp + 64);
    const float c1 = 0.125f * LOG2E;
    float m0 = -1e30f, l0 = 0.f, m1 = -1e30f, l1 = 0.f;
    f32x4 O0[4], O1[4];
#pragma unroll
    for (int d = 0; d < 4; ++d) { O0[d] = (f32x4){0.f, 0.f, 0.f, 0.f}; O1[d] = (f32x4){0.f, 0.f, 0.f, 0.f}; }
    const int kcl = kc0 + 4 * g;
    const int tb = 16 + (kcl - c + 15);
    bool va[4], vb[4];
#pragma unroll
    for (int r = 0; r < 4; ++r) { const int kca = kcl + r, kcb = kca + 16; va[r] = (kca >= cs && kca <= cs + 15); vb[r] = (kcb >= cs && kcb <= cs + 15); }
    const int Rb = (r0q - R0) * 64 + kc0;
    const LAS unsigned char* kp0 = Kl + swz(Rb + lq, g); const LAS unsigned char* kp1 = Kl + swz(Rb + lq, 4 + g);
    const LAS unsigned char* vp[4];
    { const int i = lane & 15, rq4 = i >> 2, p = i & 3;
#pragma unroll
      for (int db = 0; db < 4; ++db) vp[db] = Vl + swz(Rb + 4 * g + rq4, 2 * db + (p >> 1)) + 8 * (p & 1); }
    const LAS float* T0 = T + tb + (r0q - rq + 7) * 32;
#pragma unroll
    for (int st = 0; st < 4; ++st) {
        const int offA = st * 8192, offB = offA + 4 * 8192;
        f32x4 SA0, SA1, SB0, SB1;
        qk_at(kp0, kp1, offA, qf0, qf1, SA0, SA1);
        qk_at(kp0, kp1, offB, qf0, qf1, SB0, SB1);
        const LAS float* TA = T0 + st * 32; const LAS float* TB = TA + 4 * 32;
#pragma unroll
        for (int r = 0; r < 4; ++r) {
            const float a0 = SA0[r] * c1 + TA[r], a1 = SA1[r] * c1 + TA[16 + r], b0 = SB0[r] * c1 + TB[r], b1 = SB1[r] * c1 + TB[16 + r];
            SA0[r] = va[r] ? a0 : -INFINITY; SA1[r] = vb[r] ? a1 : -INFINITY; SB0[r] = va[r] ? b0 : -INFINITY; SB1[r] = vb[r] ? b1 : -INFINITY;
        }
        softmax_step(SA0, SA1, m0, l0, O0);
        softmax_step(SB0, SB1, m1, l1, O1);
        pv_at(vp, offA, SA0, SA1, O0);
        pv_at(vp, offB, SB0, SB1, O1);
    }
    { const float mm = fmaxf(m0, m1), a0 = __builtin_amdgcn_exp2f(m0 - mm), a1 = __builtin_amdgcn_exp2f(m1 - mm);
      l0 = l0 * a0 + l1 * a1;
#pragma unroll
      for (int d = 0; d < 4; ++d) O0[d] = O0[d] * a0 + O1[d] * a1; }
    store_o((bf16*)((unsigned char*)Y + tmo((int)qtok, 8 + h, 16)), g, l0, O0);
}

#define XB_TMO      128
#define XB_XCNT(j)  (256  + 64 * (j))
#define XB_XSUB(j)  (1280 + 64 * (j))
#define XB_XGEN(j)  (2304 + 64 * (j))
#define XB_TOP      3328
#define XB_TOPGEN   3392
#define XCD_BAR_WORDS 3456
#define XB_SPIN_CAP (1u << 18)

__device__ __forceinline__ unsigned xb_ld(unsigned* p)              { return __hip_atomic_load(p, __ATOMIC_RELAXED, __HIP_MEMORY_SCOPE_AGENT); }
__device__ __forceinline__ unsigned xb_add(unsigned* p, unsigned v) { return __hip_atomic_fetch_add(p, v, __ATOMIC_RELAXED, __HIP_MEMORY_SCOPE_AGENT); }
__device__ __forceinline__ unsigned xb_xcc_id() { return (unsigned)__builtin_amdgcn_s_getreg((3 << 11) | 20) & 0xFu; }
#define XB_SPIN(cond, bar) do { unsigned _sp = 0; while (cond) { __builtin_amdgcn_s_sleep(1); \
    if ((++_sp & 255u) == 0u) { if (xb_ld(&(bar)[XB_TMO])) break; if (_sp > XB_SPIN_CAP) { atomicAdd(&(bar)[XB_TMO], 1u); break; } } } } while (0)

struct XcdBarrier {
    unsigned* bar; unsigned x;
    volatile LAS unsigned* st;
};

__device__ __forceinline__ XcdBarrier xcd_barrier_post(unsigned* bar, volatile LAS unsigned* st) {
    XcdBarrier b; b.bar = bar; b.x = xb_xcc_id(); b.st = st;
    if (threadIdx.x == 0) (void)xb_add(&bar[XB_XCNT(b.x)], 1u);
    return b;
}
__device__ __forceinline__ void xcd_barrier_complete(unsigned* bar, unsigned x, unsigned& nloc, unsigned& nx) {
    const unsigned G = gridDim.x * gridDim.y * gridDim.z;
    unsigned sum, cnt, mine, sp = 0u;
    for (;;) {
        sum = 0u; cnt = 0u; mine = 0u;
#pragma unroll
        for (unsigned j = 0; j < 16; ++j) { const unsigned c = xb_ld(&bar[XB_XCNT(j)]); sum += c; cnt += (c > 0u) ? 1u : 0u; mine = (j == x) ? c : mine; }
        if (sum == G) break;
        __builtin_amdgcn_s_sleep(1);
        if ((++sp & 255u) == 0u) { if (xb_ld(&bar[XB_TMO])) break; if (sp > XB_SPIN_CAP) { atomicAdd(&bar[XB_TMO], 1u); break; } }
    }
    nloc = mine > 0u ? mine : 1u; nx = cnt > 0u ? cnt : 1u;
}

__device__ __forceinline__ void xcd_barrier(const XcdBarrier& b) {
    asm volatile("s_waitcnt vmcnt(0)" ::: "memory");
    __syncthreads();
    if (threadIdx.x == 0) {
        unsigned* bar = b.bar;
        __builtin_amdgcn_s_waitcnt(0);
        unsigned nloc = b.st[0], nx = b.st[1];
        if (nloc == 0u) { xcd_barrier_complete(bar, b.x, nloc, nx); b.st[0] = nloc; b.st[1] = nx; }
        const unsigned old = xb_add(&bar[XB_XSUB(b.x)], 1u);
        const unsigned gen = old / nloc;
        if (old + 1u == (gen + 1u) * nloc) {
            __builtin_amdgcn_fence(__ATOMIC_RELEASE, "agent");
            asm volatile("s_waitcnt vmcnt(0)" ::: "memory");
            const unsigned og = xb_add(&bar[XB_TOP], 1u);
            const unsigned tg = og / nx;
            if (og + 1u == (tg + 1u) * nx) xb_add(&bar[XB_TOPGEN], 1u);
            else XB_SPIN(xb_ld(&bar[XB_TOPGEN]) == tg, bar);
            __builtin_amdgcn_fence(__ATOMIC_ACQUIRE, "agent");
            xb_add(&bar[XB_XGEN(b.x)], 1u);
            asm volatile("s_waitcnt vmcnt(0)" ::: "memory");
        } else {
            XB_SPIN(xb_ld(&bar[XB_XGEN(b.x)]) == gen, bar);
            __builtin_amdgcn_fence(__ATOMIC_ACQUIRE, "agent");
            asm volatile("s_waitcnt vmcnt(0)" ::: "memory");
        }
    }
    __syncthreads();
}

struct Args { const float* in[13]; float* out; unsigned char* ws; int ph_lo, ph_hi; };
constexpr int N_PHASES = 8;
__global__ void __launch_bounds__(NTHREADS, 2) mk_fwd(Args args) {
    extern __shared__ __attribute__((aligned(16))) unsigned char lds_raw[];
    LAS unsigned char* lds = (LAS unsigned char*)lds_raw;
    const int tid = threadIdx.x, lane = tid & 63, wave = __builtin_amdgcn_readfirstlane(tid >> 6);
    const int G = gridDim.x, bx = blockIdx.x;
    const int vcu = (G % 8 == 0) ? (bx % 8) * (G / 8) + bx / 8 : bx;
    unsigned char* ws = args.ws;
    const float* x = args.in[0]; const float* norm_mix = args.in[1]; const float* w_in = args.in[2]; const float* b_gate = args.in[3];
    const float* sink = args.in[4]; const float* rpb = args.in[5]; const float* w_pa = args.in[6]; const float* w_pb = args.in[7];
    const float* w_out = args.in[8]; const float* norm_mlp = args.in[9]; const float* w_up = args.in[10]; const float* w_dn = args.in[11]; const float* norm_final = args.in[12];
    float* out = args.out;
    float* ss1 = (float*)(ws + WS_SS1); float* ss2 = (float*)(ws + WS_SS2); unsigned* cnt6 = (unsigned*)(ws + WS_CNT);
    bf16 *Win_t = (bf16*)(ws + WS_WIN), *Wpa_t = (bf16*)(ws + WS_WPA), *Wpb_t = (bf16*)(ws + WS_WPB), *Wout_t = (bf16*)(ws + WS_WOUT), *Wup_t = (bf16*)(ws + WS_WUP), *Wdn_t = (bf16*)(ws + WS_WDN);
    bf16 *XN = (bf16*)(ws + WS_XN), *YA = (bf16*)(ws + WS_YA), *YB = (bf16*)(ws + WS_YB), *MG = (bf16*)(ws + WS_MG), *X2 = (bf16*)(ws + WS_X2), *Zb = (bf16*)(ws + WS_Z), *Hb = (bf16*)(ws + WS_Z);
    const int lo = args.ph_lo, hi = args.ph_hi;
    volatile LAS unsigned* bst = (volatile LAS unsigned*)(lds + LDS_BYTES - 16);
    if (tid < 4) bst[tid] = 0u;
    __syncthreads();
    XcdBarrier bar = xcd_barrier_post((unsigned*)(ws + WS_BAR), bst);
#define IN(k) (lo <= (k) && (k) < hi)
#define SEAM(k) do { if (IN(k) && IN((k) + 1)) { if (hi > N_PHASES) cg::this_grid().sync(); else xcd_barrier(bar); } } while (0)

    if (IN(0)) {
        LAS float* scr = (LAS float*)(lds + wave * 16384);
        const int gw = vcu * NWAVES + wave, NGW = G * NWAVES;
        constexpr int I_IN = (DM / 64) * (ZLD / 32), I_P = (512 / 64) * (DM / 32), I_O = (DM / 64) * (DM / 32), I_U = (DM / 64) * (FF / 32), I_D = (FF / 64) * (DM / 32);
        constexpr int NITEMS = I_IN + 2 * I_P + I_O + I_U + I_D;
        for (int it = gw; it < NITEMS; it += NGW) {
            int r = it;
            if (r < I_IN) { p0_transpose_item(w_in, DM, ZLD, Win_t, scr, r, lane); continue; } r -= I_IN;
            if (r < I_P) { p0_transpose_item(w_pa, 512, DM, Wpa_t, scr, r, lane, nullptr, 1024, 0); continue; } r -= I_P;
            if (r < I_P) { p0_transpose_item(w_pb, 512, DM, Wpa_t, scr, r, lane, nullptr, 1024, 512); continue; } r -= I_P;
            if (r < I_O) { p0_transpose_item(w_out, DM, DM, Wout_t, scr, r, lane); continue; } r -= I_O;
            if (r < I_U) { p0_transpose_item(w_up, DM, FF, Wup_t, scr, r, lane, norm_mlp); continue; } r -= I_U;
            p0_transpose_item(w_dn, FF, DM, Wdn_t, scr, r, lane);
        }
        for (int i = bx * NTHREADS + tid; i < M; i += G * NTHREADS) { ss1[i] = 0.f; ss2[i] = 0.f; if (i < 256 * 16) cnt6[i] = 0u; }
        {
            const f32x4* gr = (const f32x4*)norm_mix + lane; f32x4 gg[4];
#pragma unroll
            for (int j = 0; j < 4; ++j) gg[j] = gr[64 * j];
            for (int mrow = gw; mrow < M; mrow += 4 * NGW) {
                f32x4 v[4][4]; float ssq[4];
#pragma unroll
                for (int r = 0; r < 4; ++r) { const f32x4* xr = (const f32x4*)(x + (size_t)min(mrow + r * NGW, M - 1) * DM) + lane;
#pragma unroll
                    for (int j = 0; j < 4; ++j) v[r][j] = __builtin_nontemporal_load(xr + 64 * j); }
#pragma unroll
                for (int r = 0; r < 4; ++r) { float t = 0.f;
#pragma unroll
                    for (int j = 0; j < 4; ++j) t += (v[r][j].x * v[r][j].x + v[r][j].y * v[r][j].y) + (v[r][j].z * v[r][j].z + v[r][j].w * v[r][j].w);
                    ssq[r] = t; }
#pragma unroll
                for (int o = 1; o < 64; o <<= 1) {
#pragma unroll
                    for (int r = 0; r < 4; ++r) ssq[r] += __shfl_xor(ssq[r], o); }
#pragma unroll
                for (int r = 0; r < 4; ++r) { const float rstd = 1.0f / sqrtf(ssq[r] * (1.f / DM) + EPS);
                    unsigned char* o8 = (unsigned char*)XN + tmo(min(mrow + r * NGW, M - 1), lane >> 4, 16) + 8 * (lane & 15);
#pragma unroll
                    for (int j = 0; j < 4; ++j) { const f32x4 t = v[r][j] * rstd * gg[j]; *(unsigned long long*)(o8 + (size_t)j * 4 * 32768) = (unsigned long long)pk2(t.x, t.y) | ((unsigned long long)pk2(t.z, t.w) << 32); } }
            }
        }
        __syncthreads();
    }
    SEAM(0);
    if (IN(1)) {
        pg8::Gemm g{XN, Win_t, M, ZLD, DM}; pg8::StaticOrder S; S.init(M, ZLD, G, bx);
        pg8::EpiPlain E{Zb, ZLD / 64, lds + 131072};
        pg8::gemm_phase<pg8::EpiPlain, pg8::StaticOrder, PG8_ALIGN, PG8_SP2>(lds, g, S, E);
    }
    SEAM(1);
    if (IN(2)) {
        {
            v4u kr[7], vr[7]; int u = vcu; const int NU = BATCH * 2 * 64;
            if (u < NU) attn_a_prefetch(Zb, u, kr, vr);
            for (; u < NU; u += G) {
                attn_a_commit(lds, kr, vr);
                __syncthreads();
                if (u + G < NU) attn_a_prefetch(Zb, u + G, kr, vr);
                asm volatile("" ::: "memory");
                attn_a_unit(lds, Zb, YA, sink, u);
                __syncthreads();
            }
        }
        {
            v4u kr[9], vr[9]; float tr[2]; int u = vcu; const int NU = BATCH * 8 * 64;
            if (u < NU) attn_b_prefetch(Zb, rpb, u, kr, vr, tr);
            for (; u < NU; u += G) {
                attn_b_commit(lds, kr, vr, tr);
                __syncthreads();
                if (u + G < NU) attn_b_prefetch(Zb, rpb, u + G, kr, vr, tr);
                asm volatile("" ::: "memory");
                attn_b_unit(lds, Zb, YA, u);
                __syncthreads();
            }
        }
    }
    SEAM(2);
    if (IN(3)) {
        pg8::Gemm g{YA, Wpa_t, M, DM, DM}; pg8::StaticOrder S; S.init(M, DM, G, bx);
        pg8::EpiGate2 E{MG, Zb, ZLD / 64, Z_GA / 64, Z_GB / 64, b_gate, lds + 131072};
        pg8::gemm_phase<pg8::EpiGate2, pg8::StaticOrder, PG8_ALIGN, PG8_SP2>(lds, g, S, E);
    }
    SEAM(3);
    if (IN(4)) {
        pg8::Gemm g{MG, Wout_t, M, DM, DM}; pg8::StaticOrder S; S.init(M, DM, G, bx);
        pg8::EpiRes1 E{x, XN, ss1, lds + 131072};
        pg8::gemm_phase<pg8::EpiRes1, pg8::StaticOrder, PG8_ALIGN, PG8_SP2>(lds, g, S, E);
    }
    SEAM(4);
    if (IN(5)) {
        pg8::Gemm g{XN, Wup_t, M, FF, DM}; pg8::StaticOrder S; S.init(M, FF, G, bx);
        pg8::EpiUp E{Hb, ss1, EPS, lds + 131072};
        pg8::gemm_phase<pg8::EpiUp, pg8::StaticOrder, PG8_ALIGN, PG8_SP2>(lds, g, S, E);
    }
    SEAM(5);
    if (IN(6)) {
        pg8::Gemm g{Hb, Wdn_t, M, DM, FF}; pg8::StaticOrder S; S.init(M, DM, G, bx);
        if (G == 256 && hi == N_PHASES && PG8_ALIGN) { pg8::EpiResNorm E{XN, out, norm_final, ss2, cnt6, EPS, lds + 131072};
            pg8::gemm_phase<pg8::EpiResNorm, pg8::StaticOrder, PG8_ALIGN, PG8_SP2>(lds, g, S, E); }
        else { pg8::EpiRes2 E{XN, X2, ss2, lds + 131072};
            pg8::gemm_phase<pg8::EpiRes2, pg8::StaticOrder, PG8_ALIGN, PG8_SP2>(lds, g, S, E); }
    }
    const bool fusedNorm = (G == 256 && hi == N_PHASES && PG8_ALIGN);
    if (!fusedNorm) SEAM(6);
    if (IN(7) && !fusedNorm) {
        const int gw = vcu * NWAVES + wave, NGW = G * NWAVES;
        const f32x4* gr = (const f32x4*)norm_final + lane;
        f32x4 gg[4];
#pragma unroll
        for (int j = 0; j < 4; ++j) gg[j] = gr[64 * j];
        for (int mrow = 4 * gw; mrow < M; mrow += 4 * NGW) {
            v2u xv[4][4]; float rstd[4];
#pragma unroll
            for (int r = 0; r < 4; ++r) { const unsigned char* xr = (const unsigned char*)X2 + tmo(mrow + r, lane >> 4, 16) + 8 * (lane & 15);
                rstd[r] = __hip_atomic_load(ss2 + mrow + r, __ATOMIC_RELAXED, __HIP_MEMORY_SCOPE_AGENT);
#pragma unroll
                for (int j = 0; j < 4; ++j) xv[r][j] = __builtin_nontemporal_load((const v2u*)(xr + (size_t)j * 4 * 32768)); }
#pragma unroll
            for (int r = 0; r < 4; ++r) { const float rs = 1.0f / sqrtf(rstd[r] * (1.f / DM) + EPS); f32x4* orow = (f32x4*)(out + (size_t)(mrow + r) * DM) + lane;
#pragma unroll
                for (int j = 0; j < 4; ++j) { const f32x4 v = {__uint_as_float(xv[r][j].x << 16), __uint_as_float(xv[r][j].x & 0xffff0000u), __uint_as_float(xv[r][j].y << 16), __uint_as_float(xv[r][j].y & 0xffff0000u)};
                    __builtin_nontemporal_store(v * rs * gg[j], orow + 64 * j); } }
        }
    }
#undef IN
#undef SEAM
}

extern "C" void kernel_launch(void* const* d_in, const int* in_sizes, int n_in, void* d_out, int out_size, void* d_ws, size_t ws_size, hipStream_t stream) {
    static int grid = 0;
    if (grid == 0) {
        if (n_in != 13 || in_sizes[0] != M * DM || out_size != M * DM || ws_size < WS_END) { fprintf(stderr, "kernel_launch: unexpected shapes (n_in %d in0 %d out %d ws %zu)\n", n_in, n_in > 0 ? in_sizes[0] : -1, out_size, ws_size); grid = -1; return; }
        int dev = 0, cus = 0, per_cu = 0;
        if (hipGetDevice(&dev) != hipSuccess || hipDeviceGetAttribute(&cus, hipDeviceAttributeMultiprocessorCount, dev) != hipSuccess) { grid = -1; return; }
        if (hipFuncSetAttribute((const void*)mk_fwd, hipFuncAttributeMaxDynamicSharedMemorySize, LDS_BYTES) != hipSuccess) { fprintf(stderr, "kernel_launch: hipFuncSetAttribute failed\n"); grid = -1; return; }
        if (hipOccupancyMaxActiveBlocksPerMultiprocessor(&per_cu, (const void*)mk_fwd, NTHREADS, LDS_BYTES) != hipSuccess || per_cu < 1) { fprintf(stderr, "kernel_launch: occupancy query says %d\n", per_cu); per_cu = 1; }
        (void)hipGetLastError();
        grid = cus * per_cu;
    }
    if (grid < 0) return;
    if (hipMemsetAsync((char*)d_ws + WS_BAR, 0, WS_BAR_BYTES, stream) != hipSuccess) { fprintf(stderr, "kernel_launch: hipMemsetAsync failed\n"); return; }
    Args a{};
    for (int i = 0; i < 13; ++i) a.in[i] = (const float*)d_in[i];
    a.out = (float*)d_out; a.ws = (unsigned char*)d_ws;
#if MK_MULTI
    for (int p = 0; p < N_PHASES; ++p) { a.ph_lo = p; a.ph_hi = p + 1; hipLaunchKernelGGL(mk_fwd, dim3(grid), dim3(NTHREADS), LDS_BYTES, stream, a); }
#else
    a.ph_lo = 0; a.ph_hi = N_PHASES;
    void* kargs[] = {&a};
    hipError_t e = hipLaunchCooperativeKernel((const void*)mk_fwd, dim3(grid), dim3(NTHREADS), kargs, LDS_BYTES, stream);
    if (e != hipSuccess) fprintf(stderr, "cooperative launch failed: %s (grid %d)\n", hipGetErrorString(e), grid);
#endif
}
```

```cpp
#include <hip/hip_runtime.h>
#include <hip/hip_cooperative_groups.h>
#include <cstdio>
#include <cstdint>
namespace cg = cooperative_groups;
namespace pg8 {
#define PG8_LAS __attribute__((address_space(3)))
typedef unsigned short bf16_t;
typedef short bf16x8 __attribute__((ext_vector_type(8)));
typedef float f32x4 __attribute__((ext_vector_type(4)));
typedef unsigned u32x4 __attribute__((ext_vector_type(4)));
constexpr int BM = 256, BK = 64, HALF = 128, HTB = HALF * BK * 2  , STAGE_BYTES = 8 * HTB, NXCD = 8, WGM = 8;

__host__ __device__ __forceinline__ int lds_byte(int r, int c) { const int st = (r >> 4) * 2 + (c >> 5), rr = r & 15, cc = c & 31, ob = rr * 64 + cc * 2; return st * 1024 + (ob ^ (((ob >> 9) & 1) << 5)); }
__host__ __device__ __forceinline__ void stage_rc(int b, int& R, int& C) { const int st = b / 1024, sb = b % 1024, swz = sb ^ (((sb >> 9) & 1) << 5); R = (st >> 1) * 16 + swz / 64; C = (st & 1) * 32 + (swz % 64) / 2; }
__host__ __device__ __forceinline__ int perm32(int rho) { const int n = rho >> 4, i = rho & 15; return 8 * (i >> 2) + 4 * n + (i & 3); }

struct Unit { int pm, pn; };
struct Gemm { const bf16_t* A; const bf16_t* Bt; int M, N, K; };

struct StaticOrder {
    int nM, nN, nwg, G, c;
    __host__ __device__ void init(int M, int N, int G_, int c_) { nM = M / BM; nN = N / BM; nwg = nM * nN; G = G_; c = c_; }
    __host__ __device__ bool next(int i, Unit& u) const {
        const long L = (long)i * G + c; if (L >= nwg) return false;
        int wgid = (int)L; { const int q = nwg / NXCD, r = nwg % NXCD, xcd = wgid % NXCD, off = wgid / NXCD; wgid = (xcd < r ? xcd * (q + 1) : r * (q + 1) + (xcd - r) * q) + off; }
        const int nig = WGM * nN, gid = wgid / nig, fm = gid * WGM, gsz = (nM - fm) < WGM ? (nM - fm) : WGM;
        u.pm = fm + ((wgid % nig) % gsz); u.pn = (wgid % nig) / gsz; return true;
    }
    __device__ __forceinline__ void a_ready(const Unit&) const {}
    __device__ __forceinline__ void done(const Unit&) const {}
};

__device__ __forceinline__ unsigned cvt_pk_bf16(float lo, float hi) { unsigned r; asm volatile("v_cvt_pk_bf16_f32 %0, %1, %2" : "=v"(r) : "v"(lo), "v"(hi)); return r; }
typedef float f32x2 __attribute__((ext_vector_type(2)));
typedef unsigned u32x2 __attribute__((ext_vector_type(2)));
__device__ __forceinline__ float bf_lo(unsigned w) { return __uint_as_float(w << 16); }
__device__ __forceinline__ float bf_hi(unsigned w) { return __uint_as_float(w & 0xffff0000u); }
__device__ __forceinline__ size_t tm_block(int pm, int ct, int nct) { return ((size_t)pm * nct + ct) * 32768; }
__device__ __forceinline__ int tm_lane(int wr, int fr, int fq) { return (wr * 64 + fr) * 128 + fq * 16; }
#define TM_PIECE(ai, m, bj) ((ai) * 16384 + (m) * 2048 + (bj) * 64)
__device__ __forceinline__ u32x4 pack8(const f32x4& v0, const f32x4& v1) { u32x4 w; w.x = cvt_pk_bf16(v0[0], v0[1]); w.y = cvt_pk_bf16(v0[2], v0[3]); w.z = cvt_pk_bf16(v1[0], v1[1]); w.w = cvt_pk_bf16(v1[2], v1[3]); return w; }
#define UNPK0(q_) ((f32x4){bf_lo((q_).x), bf_hi((q_).x), bf_lo((q_).y), bf_hi((q_).y)})
#define UNPK1(q_) ((f32x4){bf_lo((q_).z), bf_hi((q_).z), bf_lo((q_).w), bf_hi((q_).w)})

#define PG8_SCR_STRIDE 144
#define PG8_SCR_WAVE 2304
struct PieceOut { PG8_LAS unsigned char* wp; const PG8_LAS unsigned char* rp; unsigned char* ob;
    __device__ __forceinline__ PieceOut(PG8_LAS unsigned char* scr, void* O, size_t block, int wr, int wc, int fr, int fq) {
        const int lane = fq * 16 + fr; PG8_LAS unsigned char* my = scr + (wr * 4 + wc) * PG8_SCR_WAVE;
        wp = my + fr * PG8_SCR_STRIDE + fq * 16; rp = my + (lane >> 3) * PG8_SCR_STRIDE + (lane & 7) * 16; ob = (unsigned char*)O + block + (size_t)(wr * 64) * 128 + lane * 16; }
    __device__ __forceinline__ void put(int bj, const u32x4& w) const { *(PG8_LAS u32x4*)(wp + bj * 64) = w; }
    template <bool NT> __device__ __forceinline__ void flush(int ai, int m) const {
        const u32x4 r0 = *(const PG8_LAS u32x4*)rp, r1 = *(const PG8_LAS u32x4*)(rp + 8 * PG8_SCR_STRIDE);
        u32x4* p = (u32x4*)(ob + ai * 16384 + m * 2048);
        if (NT) { __builtin_nontemporal_store(r0, p); __builtin_nontemporal_store(r1, p + 64); } else { *p = r0; *(p + 64) = r1; } }
};
struct PieceIn { PG8_LAS unsigned char* wp; PG8_LAS unsigned char* rp; const unsigned char* ib;
    __device__ __forceinline__ PieceIn(PG8_LAS unsigned char* scr, const void* I, size_t block, int wr, int wc, int fr, int fq) {
        const int lane = fq * 16 + fr; PG8_LAS unsigned char* my = scr + (wr * 4 + wc) * PG8_SCR_WAVE;
        wp = my + fr * PG8_SCR_STRIDE + fq * 16; rp = my + (lane >> 3) * PG8_SCR_STRIDE + (lane & 7) * 16; ib = (const unsigned char*)I + block + (size_t)(wr * 64) * 128 + lane * 16; }
    __device__ __forceinline__ void fetch(int ai, int m, u32x4& raw0, u32x4& raw1) const { const u32x4* p = (const u32x4*)(ib + ai * 16384 + m * 2048); raw0 = *p; raw1 = *(p + 64); }
    __device__ __forceinline__ void stage(const u32x4& raw0, const u32x4& raw1) const { *(PG8_LAS u32x4*)rp = raw0; *(PG8_LAS u32x4*)(rp + 8 * PG8_SCR_STRIDE) = raw1; }
    __device__ __forceinline__ u32x4 get(int bj) const { return *(const PG8_LAS u32x4*)(wp + bj * 64); }
};
struct EpiPlain {
    static constexpr bool PERM = true, AFTER_DRAIN = false, HAS_MID = false, HAS_PRE = false;
    bf16_t* O; int nct; PG8_LAS unsigned char* scr;
    __device__ __forceinline__ void operator()(const f32x4 (&acc)[2][2][4][2], const Unit& u, int wr, int wc, int fr, int fq) const {
        const PieceOut po(scr, O, tm_block(u.pm, u.pn * 4 + wc, nct), wr, wc, fr, fq);
        const float qs = (u.pn < 2 || u.pn == 3 || u.pn == 4) ? 0.125f * 1.4426950408889634f : 1.0f;
#pragma unroll
        for (int ai = 0; ai < 2; ++ai)
#pragma unroll
            for (int m = 0; m < 4; ++m) { po.put(0, pack8(acc[ai][0][m][0] * qs, acc[ai][0][m][1] * qs)); po.put(1, pack8(acc[ai][1][m][0] * qs, acc[ai][1][m][1] * qs)); po.flush<true>(ai, m); }
    }
};
struct EpiGate2 {
    static constexpr bool PERM = true, AFTER_DRAIN = false, HAS_MID = true, HAS_PRE = false;
    bf16_t* O; const bf16_t* Z; int znct; int ga_ct, gb_ct; const float* bg; PG8_LAS unsigned char* scr;
    static __device__ __forceinline__ float eneg(float g) { return __builtin_amdgcn_exp2f(-1.4426950408889634f * fminf(fmaxf(g, -30.f), 30.f)); }
    __device__ __forceinline__ void mid(f32x4 (&acc)[2][2][4][2], const Unit& u, int wr, int wc, int fr, int fq) const {
        int pm = u.pm, cb = u.pn * 4 + wc;
        asm volatile("" : "+v"(pm), "+v"(cb));
        const PieceIn pa(scr, Z, tm_block(pm, ga_ct + cb, znct), wr, wc, fr, fq), pb(scr, Z, tm_block(pm, gb_ct + cb, znct), wr, wc, fr, fq);
        const int col0 = cb * 64 + 8 * fq;
        f32x4 ba[2][2], bb[2][2];
#pragma unroll
        for (int bj = 0; bj < 2; ++bj) { ba[bj][0] = *(const f32x4*)(bg + col0 + bj * 32); ba[bj][1] = *(const f32x4*)(bg + col0 + bj * 32 + 4); bb[bj][0] = *(const f32x4*)(bg + 1024 + col0 + bj * 32); bb[bj][1] = *(const f32x4*)(bg + 1024 + col0 + bj * 32 + 4); }
#pragma unroll
        for (int am = 0; am < 4; ++am) { const int ai = am >> 1;
            u32x4 ra[4][2], rb[4][2];
#pragma unroll
            for (int m = 2 * (am & 1); m < 2 * (am & 1) + 2; ++m) { pa.fetch(ai, m, ra[m][0], ra[m][1]); pb.fetch(ai, m, rb[m][0], rb[m][1]); }
            asm volatile("" ::: "memory");
#pragma unroll
            for (int m = 2 * (am & 1); m < 2 * (am & 1) + 2; ++m) {
                pa.stage(ra[m][0], ra[m][1]); const u32x4 ga0 = pa.get(0), ga1 = pa.get(1);
                asm volatile("" ::: "memory");
                pb.stage(rb[m][0], rb[m][1]); const u32x4 gb0 = pb.get(0), gb1 = pb.get(1);
                asm volatile("" ::: "memory");
#pragma unroll
                for (int bj = 0; bj < 2; ++bj) { const u32x4 ga = bj ? ga1 : ga0, gb = bj ? gb1 : gb0;
                    const f32x4 a0 = UNPK0(ga) + ba[bj][0], a1 = UNPK1(ga) + ba[bj][1], b0 = UNPK0(gb) + bb[bj][0], b1 = UNPK1(gb) + bb[bj][1];
#pragma unroll
                    for (int k = 0; k < 4; ++k) { acc[ai][bj][m][0][k] *= (1.0f + eneg(b0[k])) * __builtin_amdgcn_rcpf(1.0f + eneg(a0[k]));
                                                  acc[ai][bj][m][1][k] *= (1.0f + eneg(b1[k])) * __builtin_amdgcn_rcpf(1.0f + eneg(a1[k])); } } }
        }
    }
    __device__ __forceinline__ void operator()(const f32x4 (&acc)[2][2][4][2], const Unit& u, int wr, int wc, int fr, int fq) const {
        const int cb = u.pn * 4 + wc, col0 = cb * 64 + 8 * fq;
        const PieceOut po(scr, O, tm_block(u.pm, cb, 16), wr, wc, fr, fq);
        const PieceIn pb(scr, Z, tm_block(u.pm, gb_ct + cb, znct), wr, wc, fr, fq);
        f32x4 bb[2][2];
#pragma unroll
        for (int bj = 0; bj < 2; ++bj) { bb[bj][0] = *(const f32x4*)(bg + 1024 + col0 + bj * 32); bb[bj][1] = *(const f32x4*)(bg + 1024 + col0 + bj * 32 + 4); }
        u32x4 rb[2][4][2];
#pragma unroll
        for (int ai = 0; ai < 2; ++ai)
#pragma unroll
            for (int m = 0; m < 4; ++m) pb.fetch(ai, m, rb[ai][m][0], rb[ai][m][1]);
        asm volatile("" ::: "memory");
#pragma unroll
        for (int ai = 0; ai < 2; ++ai)
#pragma unroll
            for (int m = 0; m < 4; ++m) {
                pb.stage(rb[ai][m][0], rb[ai][m][1]); const u32x4 gb0 = pb.get(0), gb1 = pb.get(1);
                asm volatile("" ::: "memory");
#pragma unroll
                for (int bj = 0; bj < 2; ++bj) { const u32x4 gb = bj ? gb1 : gb0;
                    const f32x4 b0 = UNPK0(gb) + bb[bj][0], b1 = UNPK1(gb) + bb[bj][1];
                    f32x4 v0 = acc[ai][bj][m][0], v1 = acc[ai][bj][m][1];
#pragma unroll
                    for (int k = 0; k < 4; ++k) { v0[k] *= __builtin_amdgcn_rcpf(1.0f + eneg(b0[k])); v1[k] *= __builtin_amdgcn_rcpf(1.0f + eneg(b1[k])); }
                    po.put(bj, pack8(v0, v1)); }
                po.flush<false>(ai, m);
                asm volatile("" ::: "memory"); }
    }
};
struct EpiRes1 {
    static constexpr bool PERM = true, AFTER_DRAIN = false, HAS_MID = false, HAS_PRE = false;
    const float* x; bf16_t* X1; float* ss; PG8_LAS unsigned char* scr;
    __device__ __forceinline__ void operator()(const f32x4 (&acc)[2][2][4][2], const Unit& u, int wr, int wc, int fr, int fq) const {
        const int row0 = u.pm * BM + wr * 64 + fr, col0 = u.pn * BM + wc * 64 + 8 * fq;
        const PieceOut po(scr, X1, tm_block(u.pm, u.pn * 4 + wc, 16), wr, wc, fr, fq);
#pragma unroll
        for (int ai = 0; ai < 2; ++ai) {
            f32x4 xv[4][2][2];
#pragma unroll
            for (int m = 0; m < 4; ++m) { const float* xp = x + (size_t)(row0 + ai * HALF + m * 16) * 1024 + col0;
#pragma unroll
                for (int bj = 0; bj < 2; ++bj) { xv[m][bj][0] = *(const f32x4*)(xp + bj * 32); xv[m][bj][1] = *(const f32x4*)(xp + bj * 32 + 4); } }
            asm volatile("" ::: "memory");
#pragma unroll
            for (int m = 0; m < 4; ++m) { const int row = row0 + ai * HALF + m * 16; float sq = 0.f;
#pragma unroll
                for (int bj = 0; bj < 2; ++bj) { const f32x4 o0 = xv[m][bj][0] + acc[ai][bj][m][0], o1 = xv[m][bj][1] + acc[ai][bj][m][1];
                    sq += ((o0[0] * o0[0] + o0[1] * o0[1]) + (o0[2] * o0[2] + o0[3] * o0[3])) + ((o1[0] * o1[0] + o1[1] * o1[1]) + (o1[2] * o1[2] + o1[3] * o1[3]));
                    po.put(bj, pack8(o0, o1)); }
                po.flush<false>(ai, m);
                sq += __shfl_xor(sq, 16); sq += __shfl_xor(sq, 32);
                if (fq == 0) atomicAdd(ss + row, sq); }
        }
    }
};
struct EpiRes2 {
    static constexpr bool PERM = true, AFTER_DRAIN = false, HAS_MID = false, HAS_PRE = false;
    const bf16_t* X1; bf16_t* X2; float* ss; PG8_LAS unsigned char* scr;
    __device__ __forceinline__ void operator()(const f32x4 (&acc)[2][2][4][2], const Unit& u, int wr, int wc, int fr, int fq) const {
        const int row0 = u.pm * BM + wr * 64 + fr;
        const size_t blk = tm_block(u.pm, u.pn * 4 + wc, 16);
        const PieceIn pi(scr, X1, blk, wr, wc, fr, fq); const PieceOut po(scr, X2, blk, wr, wc, fr, fq);
        u32x4 rx[2][4][2];
#pragma unroll
        for (int ai = 0; ai < 2; ++ai)
#pragma unroll
            for (int m = 0; m < 4; ++m) pi.fetch(ai, m, rx[ai][m][0], rx[ai][m][1]);
        asm volatile("" ::: "memory");
#pragma unroll
        for (int ai = 0; ai < 2; ++ai)
#pragma unroll
            for (int m = 0; m < 4; ++m) { const int row = row0 + ai * HALF + m * 16; float sq = 0.f;
                pi.stage(rx[ai][m][0], rx[ai][m][1]); const u32x4 x0 = pi.get(0), x1 = pi.get(1);
                asm volatile("" ::: "memory");
#pragma unroll
                for (int bj = 0; bj < 2; ++bj) { const u32x4 z4 = bj ? x1 : x0;
                    const f32x4 o0 = UNPK0(z4) + acc[ai][bj][m][0], o1 = UNPK1(z4) + acc[ai][bj][m][1];
                    sq += ((o0[0] * o0[0] + o0[1] * o0[1]) + (o0[2] * o0[2] + o0[3] * o0[3])) + ((o1[0] * o1[0] + o1[1] * o1[1]) + (o1[2] * o1[2] + o1[3] * o1[3]));
                    po.put(bj, pack8(o0, o1)); }
                po.flush<false>(ai, m);
                asm volatile("" ::: "memory");
                sq += __shfl_xor(sq, 16); sq += __shfl_xor(sq, 32);
                if (fq == 0) atomicAdd(ss + row, sq); }
    }
};
struct EpiResNorm {
    static constexpr bool PERM = true, AFTER_DRAIN = false, HAS_MID = false, HAS_PRE = false;
    const bf16_t* X1; float* out; const float* gw; float* ss; unsigned* cnt; float eps; PG8_LAS unsigned char* scr;
    __device__ __forceinline__ void operator()(f32x4 (&acc)[2][2][4][2], const Unit& u, int wr, int wc, int fr, int fq) const {
        const int lane = fq * 16 + fr, row0 = u.pm * BM + wr * 64 + fr;
        const PieceIn pi(scr, X1, tm_block(u.pm, u.pn * 4 + wc, 16), wr, wc, fr, fq);
        u32x4 rx[2][4][2];
#pragma unroll
        for (int ai = 0; ai < 2; ++ai)
#pragma unroll
            for (int m = 0; m < 4; ++m) pi.fetch(ai, m, rx[ai][m][0], rx[ai][m][1]);
        asm volatile("" ::: "memory");
#pragma unroll
        for (int ai = 0; ai < 2; ++ai)
#pragma unroll
            for (int m = 0; m < 4; ++m) { const int row = row0 + ai * HALF + m * 16; float sq = 0.f;
                pi.stage(rx[ai][m][0], rx[ai][m][1]); const u32x4 x0 = pi.get(0), x1 = pi.get(1);
                asm volatile("" ::: "memory");
#pragma unroll
                for (int bj = 0; bj < 2; ++bj) { const u32x4 z4 = bj ? x1 : x0;
                    const f32x4 o0 = UNPK0(z4) + acc[ai][bj][m][0], o1 = UNPK1(z4) + acc[ai][bj][m][1];
                    acc[ai][bj][m][0] = o0; acc[ai][bj][m][1] = o1;
                    sq += ((o0[0] * o0[0] + o0[1] * o0[1]) + (o0[2] * o0[2] + o0[3] * o0[3])) + ((o1[0] * o1[0] + o1[1] * o1[1]) + (o1[2] * o1[2] + o1[3] * o1[3])); }
                sq += __shfl_xor(sq, 16); sq += __shfl_xor(sq, 32);
                if (fq == 0) atomicAdd(ss + row, sq); }
        asm volatile("s_waitcnt vmcnt(0)" ::: "memory");
        unsigned* c = cnt + 16 * u.pm;
        if (lane == 0) __hip_atomic_fetch_add(c, 1u, __ATOMIC_RELAXED, __HIP_MEMORY_SCOPE_AGENT);
        if (wr == 0 && wc == 0) { while (__hip_atomic_load(c, __ATOMIC_RELAXED, __HIP_MEMORY_SCOPE_AGENT) < 32u) __builtin_amdgcn_s_sleep(4); }
        asm volatile("s_waitcnt vmcnt(0) lgkmcnt(0)" ::: "memory"); __builtin_amdgcn_s_barrier(); asm volatile("" ::: "memory");
        float rs[2][4];
#pragma unroll
        for (int ai = 0; ai < 2; ++ai)
#pragma unroll
            for (int m = 0; m < 4; ++m) rs[ai][m] = __hip_atomic_load(ss + row0 + ai * HALF + m * 16, __ATOMIC_RELAXED, __HIP_MEMORY_SCOPE_AGENT);
        PG8_LAS unsigned char* my = scr + (wr * 4 + wc) * PG8_SCR_WAVE;
        PG8_LAS unsigned char* gp = my + fr * PG8_SCR_STRIDE + fq * 32;
        const PG8_LAS unsigned char* sp = my + (lane >> 3) * PG8_SCR_STRIDE + (lane & 7) * 16;
        float* ob = out + (size_t)(u.pm * BM + wr * 64 + (lane >> 3)) * 1024 + u.pn * BM + wc * 64 + (lane & 7) * 4;
        const int col0 = u.pn * BM + wc * 64 + 8 * fq;
#pragma unroll
        for (int bj = 0; bj < 2; ++bj) { const f32x4 g0 = *(const f32x4*)(gw + col0 + bj * 32), g1 = *(const f32x4*)(gw + col0 + bj * 32 + 4);
#pragma unroll
            for (int ai = 0; ai < 2; ++ai)
#pragma unroll
                for (int m = 0; m < 4; ++m) { const float r = __builtin_amdgcn_rsqf(rs[ai][m] * (1.0f / 1024.0f) + eps);
                    *(PG8_LAS f32x4*)gp = acc[ai][bj][m][0] * r * g0; *(PG8_LAS f32x4*)(gp + 16) = acc[ai][bj][m][1] * r * g1;
                    const f32x4 v0 = *(const PG8_LAS f32x4*)sp, v1 = *(const PG8_LAS f32x4*)(sp + 8 * PG8_SCR_STRIDE);
                    float* op = ob + (size_t)(ai * HALF + m * 16) * 1024 + bj * 32;
                    __builtin_nontemporal_store(v0, (f32x4*)op); __builtin_nontemporal_store(v1, (f32x4*)(op + 8 * 1024));
                    asm volatile("" ::: "memory"); } }
    }
};
struct EpiUp {
    static constexpr bool PERM = true, AFTER_DRAIN = false, HAS_MID = false, HAS_PRE = true;
    bf16_t* O; const float* ss; float eps; PG8_LAS unsigned char* scr;
    __device__ __forceinline__ void pre(float (&st)[8], const Unit& u, int wr, int wc, int fr, int fq) const {
        const float* sp = ss + u.pm * BM + wr * 64 + fr;
#pragma unroll
        for (int i = 0; i < 8; ++i) st[i] = sp[(i >> 2) * HALF + (i & 3) * 16];
    }
    __device__ __forceinline__ void post(const f32x4 (&acc)[2][2][4][2], const float (&st)[8], const Unit& u, int wr, int wc, int fr, int fq) const {
        const PieceOut po(scr, O, tm_block(u.pm, u.pn * 4 + wc, 64), wr, wc, fr, fq);
#pragma unroll
        for (int ai = 0; ai < 2; ++ai)
#pragma unroll
            for (int m = 0; m < 4; ++m) { const float rs = __builtin_amdgcn_rsqf(st[ai * 4 + m] * (1.0f / 1024.0f) + eps);
#pragma unroll
                for (int bj = 0; bj < 2; ++bj) { f32x4 v0 = acc[ai][bj][m][0] * rs, v1 = acc[ai][bj][m][1] * rs;
#pragma unroll
                    for (int k = 0; k < 4; ++k) { const float a = fmaxf(v0[k], 0.f), b = fmaxf(v1[k], 0.f); v0[k] = a * a; v1[k] = b * b; }
                    po.put(bj, pack8(v0, v1)); }
                po.flush<true>(ai, m); }
    }
};
template <class Epi, class Sched, bool ALIGN_EPI = false, bool SP2 = false>
__device__ __forceinline__ void gemm_phase(PG8_LAS unsigned char* lds, const Gemm g, const Sched& S, const Epi& E) {
    const int tid = threadIdx.x, wid = __builtin_amdgcn_readfirstlane(tid >> 6), lane = tid & 63, wr = wid >> 2, wc = wid & 3, fr = lane & 15, fq = lane >> 4;
    const int K = g.K, nt = K / BK;
    unsigned voffA[2], voffB[2];
#pragma unroll
    for (int i = 0; i < 2; ++i) { int R, C; stage_rc(tid * 16 + i * 8192, R, C); const int Rb = Epi::PERM ? (64 * (R >> 5) + perm32(R & 31)) : R;
        voffA[i] = (unsigned)(R * 64 + C) * 2u; voffB[i] = (unsigned)(Rb * 64 + C) * 2u; }
    const size_t kstep = (size_t)32768;
    const size_t hstep = (size_t)HALF * 128;
    const size_t tstep = (size_t)256 * K * 2; const size_t hstepB = Epi::PERM ? (size_t)32 * 128 : hstep;
    const unsigned ldsw = (unsigned)wid * 1024u;
    const int aoff = lds_byte(wr * 64 + fr, fq * 8), boff = lds_byte(wc * 32 + fr, fq * 8);
#define PG8_SA(b, h) (((b) * 2 + (h)) * HTB)
#define PG8_SB(b, h) ((4 + (b) * 2 + (h)) * HTB)
#define PG8_STAGE(bufoff, gbase, voff) do { _Pragma("unroll") for (int _i = 0; _i < 2; ++_i) \
        __builtin_amdgcn_global_load_lds((const unsigned*)((const char*)(gbase) + (voff)[_i]), (PG8_LAS unsigned*)(lds + (bufoff) + ldsw + _i * 8192), 16, 0, 0); } while (0)
#define PG8_LDA(dst, b, h) do { _Pragma("unroll") for (int m = 0; m < 4; ++m) _Pragma("unroll") for (int k = 0; k < 2; ++k) dst[m][k] = *(const PG8_LAS bf16x8*)(lds + PG8_SA(b, h) + aoff + m * 2048 + k * 1024); } while (0)
#define PG8_LDB(dst, b, h) do { _Pragma("unroll") for (int n = 0; n < 2; ++n) _Pragma("unroll") for (int k = 0; k < 2; ++k) dst[n][k] = *(const PG8_LAS bf16x8*)(lds + PG8_SB(b, h) + boff + n * 2048 + k * 1024); } while (0)
#define PG8_MMA(ai, bj, At, Bt) do { __builtin_amdgcn_s_setprio(1); _Pragma("unroll") for (int m = 0; m < 4; ++m) _Pragma("unroll") for (int n = 0; n < 2; ++n) _Pragma("unroll") for (int k = 0; k < 2; ++k) \
        acc[ai][bj][m][n] = __builtin_amdgcn_mfma_f32_16x16x32_bf16(Bt[n][k], At[m][k], acc[ai][bj][m][n], 0, 0, 0); __builtin_amdgcn_s_setprio(0); } while (0)
#define PG8_WAIT_V(n) asm volatile("s_waitcnt vmcnt(" #n ")" ::: "memory")
#define PG8_WAIT_L(n) asm volatile("s_waitcnt lgkmcnt(" #n ")" ::: "memory")
#define PG8_BAR __builtin_amdgcn_s_barrier()
#define PG8_SCHED __builtin_amdgcn_sched_barrier(0)
    Unit cur, nxt; int ui = 0;
    if (!S.next(0, cur)) return;
    f32x4 acc[2][2][4][2];
#pragma unroll
    for (int a = 0; a < 2; ++a)
#pragma unroll
        for (int b = 0; b < 2; ++b)
#pragma unroll
            for (int m = 0; m < 4; ++m)
#pragma unroll
                for (int n = 0; n < 2; ++n) acc[a][b][m][n] = (f32x4){0.f, 0.f, 0.f, 0.f};
    bf16x8 At[4][2], B0[2][2], B1[2][2];
    const char* cA = (const char*)g.A + (size_t)cur.pm * tstep; const char* cB = (const char*)g.Bt + (size_t)cur.pn * tstep;
    S.a_ready(cur);
    float pre_st[8];
    if constexpr (Epi::HAS_PRE) E.pre(pre_st, cur, wr, wc, fr, fq);
    if constexpr (SP2) {
        PG8_STAGE(PG8_SB(0, 0), cB, voffB); PG8_STAGE(PG8_SB(0, 1), cB + hstepB, voffB); PG8_STAGE(PG8_SA(0, 0), cA, voffA); PG8_STAGE(PG8_SA(0, 1), cA + hstep, voffA);
        if (wr == 1) PG8_BAR;
        PG8_WAIT_V(2); PG8_BAR;
        PG8_STAGE(PG8_SB(1, 0), cB + kstep, voffB); PG8_STAGE(PG8_SA(1, 0), cA + kstep, voffA); PG8_STAGE(PG8_SB(1, 1), cB + hstepB + kstep, voffB);
        PG8_WAIT_V(6); PG8_BAR;
    } else {
        PG8_STAGE(PG8_SB(0, 0), cB, voffB); PG8_STAGE(PG8_SA(0, 0), cA, voffA); PG8_STAGE(PG8_SB(0, 1), cB + hstepB, voffB); PG8_STAGE(PG8_SA(0, 1), cA + hstep, voffA);
        if (wr == 1) PG8_BAR;
        PG8_WAIT_V(4); PG8_BAR;
        PG8_STAGE(PG8_SB(1, 0), cB + kstep, voffB); PG8_STAGE(PG8_SA(1, 0), cA + kstep, voffA); PG8_STAGE(PG8_SB(1, 1), cB + hstepB + kstep, voffB);
        PG8_WAIT_V(6); PG8_BAR;
    }
    for (;;) {
        const bool has_next = S.next(ui + 1, nxt);
        const char* nA = has_next ? (const char*)g.A + (size_t)nxt.pm * tstep : cA; const char* nB = has_next ? (const char*)g.Bt + (size_t)nxt.pn * tstep : cB;
        for (int t = 0; t < nt; t += 2) {
            if constexpr (Epi::HAS_MID) { if (t == (nt >> 1)) E.mid(acc, cur, wr, wc, fr, fq); }
            const bool last = (t == nt - 2);
            const char* a1 = cA + (size_t)(t + 1) * kstep;
            const char* a2 = last ? nA : cA + (size_t)(t + 2) * kstep; const char* b2 = last ? nB : cB + (size_t)(t + 2) * kstep;
            const char* a3 = a2 + kstep; const char* b3 = b2 + kstep;
            if (last && has_next) S.a_ready(nxt);
            if constexpr (SP2) {
            PG8_LDB(B0, 0, 0); PG8_LDB(B1, 0, 1); PG8_SCHED; PG8_LDA(At, 0, 0); PG8_STAGE(PG8_SA(1, 1), a1 + hstep, voffA);
            PG8_WAIT_V(8); PG8_WAIT_L(0); PG8_BAR; PG8_MMA(0, 0, At, B0); PG8_MMA(0, 1, At, B1); PG8_BAR; PG8_SCHED;
            PG8_LDA(At, 0, 1); PG8_STAGE(PG8_SB(0, 0), b2, voffB); PG8_STAGE(PG8_SB(0, 1), b2 + hstepB, voffB); PG8_STAGE(PG8_SA(0, 0), a2, voffA);
            PG8_WAIT_V(8); PG8_WAIT_L(0); PG8_BAR; PG8_MMA(1, 0, At, B0); PG8_MMA(1, 1, At, B1); PG8_BAR; PG8_SCHED;
            PG8_LDB(B0, 1, 0); PG8_LDB(B1, 1, 1); PG8_SCHED; PG8_LDA(At, 1, 0); PG8_STAGE(PG8_SA(0, 1), a2 + hstep, voffA);
            PG8_WAIT_V(8); PG8_WAIT_L(0); PG8_BAR; PG8_MMA(0, 0, At, B0); PG8_MMA(0, 1, At, B1); PG8_BAR; PG8_SCHED;
            PG8_LDA(At, 1, 1); PG8_STAGE(PG8_SB(1, 0), b3, voffB); PG8_STAGE(PG8_SB(1, 1), b3 + hstepB, voffB); PG8_STAGE(PG8_SA(1, 0), a3, voffA);
            PG8_WAIT_V(8); PG8_WAIT_L(0); PG8_BAR; PG8_MMA(1, 0, At, B0); PG8_MMA(1, 1, At, B1); PG8_BAR; PG8_SCHED;
            } else {
            PG8_LDB(B0, 0, 0); PG8_SCHED; PG8_LDA(At, 0, 0); PG8_STAGE(PG8_SA(1, 1), a1 + hstep, voffA);
            PG8_WAIT_L(8); PG8_BAR; PG8_WAIT_L(0); PG8_MMA(0, 0, At, B0); PG8_BAR; PG8_SCHED;
            PG8_LDB(B1, 0, 1); PG8_STAGE(PG8_SB(0, 0), b2, voffB);
            PG8_BAR; PG8_WAIT_L(0); PG8_MMA(0, 1, At, B1); PG8_BAR;
            PG8_LDA(At, 0, 1); PG8_STAGE(PG8_SA(0, 0), a2, voffA);
            PG8_BAR; PG8_WAIT_L(0); PG8_MMA(1, 0, At, B0); PG8_BAR; PG8_SCHED;
            PG8_STAGE(PG8_SB(0, 1), b2 + hstepB, voffB);
            PG8_WAIT_V(6); PG8_BAR; PG8_MMA(1, 1, At, B1); PG8_BAR;
            PG8_LDB(B0, 1, 0); PG8_SCHED; PG8_LDA(At, 1, 0); PG8_STAGE(PG8_SA(0, 1), a2 + hstep, voffA);
            PG8_WAIT_L(8); PG8_BAR; PG8_WAIT_L(0); PG8_MMA(0, 0, At, B0); PG8_BAR; PG8_SCHED;
            PG8_LDB(B1, 1, 1); PG8_STAGE(PG8_SB(1, 0), b3, voffB);
            PG8_BAR; PG8_WAIT_L(0); PG8_MMA(0, 1, At, B1); PG8_BAR;
            PG8_LDA(At, 1, 1); PG8_STAGE(PG8_SA(1, 0), a3, voffA);
            PG8_BAR; PG8_WAIT_L(0); PG8_MMA(1, 0, At, B0); PG8_BAR; PG8_SCHED;
            PG8_STAGE(PG8_SB(1, 1), b3 + hstepB, voffB);
            PG8_WAIT_V(6); PG8_BAR; PG8_MMA(1, 1, At, B1); PG8_BAR;
            }
        }
        if constexpr (ALIGN_EPI) { if (wr == 0) PG8_BAR; }
        if constexpr (!Epi::AFTER_DRAIN) { if constexpr (Epi::HAS_PRE) { E.post(acc, pre_st, cur, wr, wc, fr, fq); if (has_next) E.pre(pre_st, nxt, wr, wc, fr, fq); } else E(acc, cur, wr, wc, fr, fq); S.done(cur); }
        if (!has_next) break;
#pragma unroll
        for (int a = 0; a < 2; ++a)
#pragma unroll
            for (int b = 0; b < 2; ++b)
#pragma unroll
                for (int m = 0; m < 4; ++m)
#pragma unroll
                    for (int n = 0; n < 2; ++n) acc[a][b][m][n] = (f32x4){0.f, 0.f, 0.f, 0.f};
        cur = nxt; cA = nA; cB = nB; ++ui;
        if constexpr (ALIGN_EPI) { if (wr == 1) PG8_BAR; }
    }
    PG8_WAIT_V(0);
    if constexpr (!ALIGN_EPI) { if (wr == 0) PG8_BAR; }
    PG8_BAR;
    if constexpr (Epi::AFTER_DRAIN) { E.fused(acc, cur, wr, wc, fr, fq, lds, wid, lane); S.done(cur); }
#undef PG8_SA
#undef PG8_SB
#undef PG8_STAGE
#undef PG8_LDA
#undef PG8_LDB
#undef PG8_MMA
#undef PG8_WAIT_V
#undef PG8_WAIT_L
#undef PG8_BAR
#undef PG8_SCHED
}
}
#ifndef PG8_SP2
#define PG8_SP2 true
#endif
#ifndef PG8_ALIGN
#define PG8_ALIGN true
#endif
#ifndef MK_MULTI
#define MK_MULTI 0
#endif

constexpr int BATCH = 8, SEQ = 8192, DM = 1024, FF = 4096, M = BATCH * SEQ;
constexpr int ZLD = 4352;
constexpr int Z_QA = 0, Z_KA = 512, Z_VA = 640, Z_QB = 768, Z_KB = 1280, Z_VB = 1792, Z_GA = 2304, Z_GB = 3328;
constexpr float EPS = 1e-6f, LOG2E = 1.4426950408889634f;
constexpr int NWAVES = 8, NTHREADS = 512;
constexpr size_t MiB = 1u << 20;
constexpr size_t WS_SS1 = 0, WS_SS2 = 256 * 1024, WS_CNT = 512 * 1024, WS_BAR = 768 * 1024, WS_BAR_BYTES = 16384;
constexpr size_t WS_WIN = 1 * MiB;
constexpr size_t WS_WPA = 10 * MiB, WS_WPB = 11 * MiB;
constexpr size_t WS_WOUT = 12 * MiB;
constexpr size_t WS_WUP = 14 * MiB;
constexpr size_t WS_WDN = 22 * MiB;
constexpr size_t WS_XN = 32 * MiB;
constexpr size_t WS_YA = 160 * MiB, WS_YB = 224 * MiB;
constexpr size_t WS_X2 = 160 * MiB;
constexpr size_t WS_MG = 288 * MiB;
constexpr size_t WS_Z = 416 * MiB;
constexpr size_t WS_END = 960 * MiB;
constexpr int LDS_BYTES = 155648;
#define LAS __attribute__((address_space(3)))
typedef unsigned short bf16;
typedef unsigned v4u __attribute__((ext_vector_type(4)));
typedef unsigned v2u __attribute__((ext_vector_type(2)));
typedef float f32x4 __attribute__((ext_vector_type(4)));
typedef short bf16x8 __attribute__((ext_vector_type(8)));
typedef short s16x4 __attribute__((ext_vector_type(4)));
#define LDS_WAIT() asm volatile("s_waitcnt lgkmcnt(0)" ::: "memory")
__device__ __forceinline__ unsigned f2bf(float f) { unsigned u = __builtin_bit_cast(unsigned, f); return (u + 0x7fffu + ((u >> 16) & 1u)) >> 16; }
__device__ __forceinline__ unsigned pk2(float lo, float hi) { return pg8::cvt_pk_bf16(lo, hi); }
__device__ __forceinline__ float wave_sum(float v) {
#pragma unroll
    for (int o = 1; o < 64; o <<= 1) v += __shfl_xor(v, o);
    return v;
}
__device__ __forceinline__ size_t tmo(int row, int ct, int nct) { return ((size_t)(row >> 8) * nct + ct) * 32768 + (size_t)(row & 255) * 128; }
__device__ __forceinline__ void p0_transpose_item(const float* W, int K, int N, bf16* WT, LAS float* scr, int item, int lane, const float* gk = nullptr, int ldw = 0, int koff = 0) {
    if (ldw == 0) ldw = K;
    const int nblk = N / 32, kb = item / nblk, nb = item % nblk, k0 = 64 * kb, n0 = 32 * nb;
#pragma unroll 8
    for (int i = 0; i < 32; ++i) { const int kk = 2 * i + (lane >> 5); scr[kk * 33 + (lane & 31)] = W[(size_t)(k0 + kk) * N + n0 + (lane & 31)] * (gk ? gk[k0 + kk] : 1.0f); }
    LDS_WAIT(); asm volatile("" ::: "memory");
    const int c = lane & 7;
#pragma unroll
    for (int j = 0; j < 4; ++j) { const int n = (lane >> 3) + 8 * j; const LAS float* s = scr + (8 * c) * 33 + n;
        v4u o; o.x = pk2(s[0 * 33], s[1 * 33]); o.y = pk2(s[2 * 33], s[3 * 33]); o.z = pk2(s[4 * 33], s[5 * 33]); o.w = pk2(s[6 * 33], s[7 * 33]);
        *(v4u*)((unsigned char*)WT + tmo(n0 + n, (koff + k0) >> 6, ldw >> 6) + 16 * c) = o; }
    LDS_WAIT(); asm volatile("" ::: "memory");
}
__device__ __forceinline__ void rms_row_to_bf16(const float* xrow, const float* g, bf16* orow, int lane) {
    const f32x4* xr = (const f32x4*)xrow + lane; const f32x4* gr = (const f32x4*)g + lane;
    f32x4 v[4]; float s = 0.f;
#pragma unroll
    for (int j = 0; j < 4; ++j) { v[j] = xr[64 * j]; s += (v[j].x * v[j].x + v[j].y * v[j].y) + (v[j].z * v[j].z + v[j].w * v[j].w); }
    const float rstd = 1.0f / sqrtf(wave_sum(s) * (1.f / DM) + EPS);
    unsigned long long* o8 = (unsigned long long*)orow + lane;
#pragma unroll
    for (int j = 0; j < 4; ++j) { const f32x4 gg = gr[64 * j]; const f32x4 t = v[j] * rstd * gg;
        o8[64 * j] = (unsigned long long)pk2(t.x, t.y) | ((unsigned long long)pk2(t.z, t.w) << 32); }
}
__device__ __forceinline__ int swz(int row, int chunk) { return row * 128 + ((chunk ^ (row & 7)) << 4); }
__device__ __forceinline__ s16x4 vtr(const LAS unsigned char* p) { return __builtin_bit_cast(s16x4, __builtin_amdgcn_ds_read_tr16_b64_v4i16((LAS s16x4*)p)); }
#define MFMA16(a, b, c) __builtin_amdgcn_mfma_f32_16x16x32_bf16((a), (b), (c), 0, 0, 0)

__device__ __forceinline__ void qk_step(const LAS unsigned char* Kl, int rb0, int rb1, int lq, int g, bf16x8 qf0, bf16x8 qf1, f32x4& S0, f32x4& S1) {
    const bf16x8 k00 = *(const LAS bf16x8*)(Kl + swz(rb0 + lq, g)), k01 = *(const LAS bf16x8*)(Kl + swz(rb0 + lq, 4 + g));
    const bf16x8 k10 = *(const LAS bf16x8*)(Kl + swz(rb1 + lq, g)), k11 = *(const LAS bf16x8*)(Kl + swz(rb1 + lq, 4 + g));
    const f32x4 z = {0.f, 0.f, 0.f, 0.f};
    S0 = MFMA16(k00, qf0, z); S0 = MFMA16(k01, qf1, S0);
    S1 = MFMA16(k10, qf0, z); S1 = MFMA16(k11, qf1, S1);
}
__device__ __forceinline__ void pv_step(const LAS unsigned char* Vl, int rb0, int rb1, int lane, int g, const f32x4& P0, const f32x4& P1, f32x4 (&O)[4]) {
    v4u pw; pw.x = pk2(P0[0], P0[1]); pw.y = pk2(P0[2], P0[3]); pw.z = pk2(P1[0], P1[1]); pw.w = pk2(P1[2], P1[3]);
    const bf16x8 pb = __builtin_bit_cast(bf16x8, pw);
    const int i = lane & 15, rq = i >> 2, p = i & 3;
    const int r0 = rb0 + 4 * g + rq, r1 = rb1 + 4 * g + rq;
#pragma unroll
    for (int db = 0; db < 4; ++db) {
        const s16x4 lo = vtr(Vl + swz(r0, 2 * db + (p >> 1)) + 8 * (p & 1));
        const s16x4 hi = vtr(Vl + swz(r1, 2 * db + (p >> 1)) + 8 * (p & 1));
        const bf16x8 vt = (bf16x8){lo[0], lo[1], lo[2], lo[3], hi[0], hi[1], hi[2], hi[3]};
        O[db] = MFMA16(vt, pb, O[db]);
    }
}
__device__ __forceinline__ void qk_at(const LAS unsigned char* kp0, const LAS unsigned char* kp1, int off, bf16x8 qf0, bf16x8 qf1, f32x4& S0, f32x4& S1) {
    const bf16x8 k00 = *(const LAS bf16x8*)(kp0 + off), k01 = *(const LAS bf16x8*)(kp1 + off);
    const bf16x8 k10 = *(const LAS bf16x8*)(kp0 + off + 2048), k11 = *(const LAS bf16x8*)(kp1 + off + 2048);
    const f32x4 z = {0.f, 0.f, 0.f, 0.f};
    S0 = MFMA16(k00, qf0, z); S0 = MFMA16(k01, qf1, S0);
    S1 = MFMA16(k10, qf0, z); S1 = MFMA16(k11, qf1, S1);
}
__device__ __forceinline__ void pv_at(const LAS unsigned char* const (&vp)[4], int off, const f32x4& P0, const f32x4& P1, f32x4 (&O)[4]) {
    v4u pw; pw.x = pk2(P0[0], P0[1]); pw.y = pk2(P0[2], P0[3]); pw.z = pk2(P1[0], P1[1]); pw.w = pk2(P1[2], P1[3]);
    const bf16x8 pb = __builtin_bit_cast(bf16x8, pw);
#pragma unroll
    for (int db = 0; db < 4; ++db) {
        const s16x4 lo = vtr(vp[db] + off), hi = vtr(vp[db] + off + 2048);
        const bf16x8 vt = (bf16x8){lo[0], lo[1], lo[2], lo[3], hi[0], hi[1], hi[2], hi[3]};
        O[db] = MFMA16(vt, pb, O[db]);
    }
}
__device__ __forceinline__ float xrow16_max(float x) {
    auto s = __builtin_amdgcn_permlane16_swap(__float_as_uint(x), __float_as_uint(x), false, false);
    x = fmaxf(__uint_as_float(s[0]), __uint_as_float(s[1]));
    auto t = __builtin_amdgcn_permlane32_swap(__float_as_uint(x), __float_as_uint(x), false, false);
    return fmaxf(__uint_as_float(t[0]), __uint_as_float(t[1]));
}
__device__ __forceinline__ float xrow16_sum(float x) {
    auto s = __builtin_amdgcn_permlane16_swap(__float_as_uint(x), __float_as_uint(x), false, false);
    x = __uint_as_float(s[0]) + __uint_as_float(s[1]);
    auto t = __builtin_amdgcn_permlane32_swap(__float_as_uint(x), __float_as_uint(x), false, false);
    return __uint_as_float(t[0]) + __uint_as_float(t[1]);
}
__device__ __forceinline__ void softmax_step(f32x4& s0, f32x4& s1, float& m, float& l, f32x4 (&O)[4]) {
    float t = fmaxf(fmaxf(fmaxf(s0[0], s0[1]), fmaxf(s0[2], s0[3])), fmaxf(fmaxf(s1[0], s1[1]), fmaxf(s1[2], s1[3])));
    t = xrow16_max(t);
    const float mn = fmaxf(m, t), alpha = __builtin_amdgcn_exp2f(m - mn);
    m = mn;
#pragma unroll
    for (int k = 0; k < 4; ++k) { s0[k] = __builtin_amdgcn_exp2f(s0[k] - mn); s1[k] = __builtin_amdgcn_exp2f(s1[k] - mn); }
    l = l * alpha + ((s0[0] + s0[1]) + (s0[2] + s0[3])) + ((s1[0] + s1[1]) + (s1[2] + s1[3]));
#pragma unroll
    for (int db = 0; db < 4; ++db) O[db] *= alpha;
}
__device__ __forceinline__ void store_o(bf16* yrow, int g, float l, const f32x4 (&O)[4]) {
    const float inv = 1.0f / xrow16_sum(l);
    unsigned wx[4], wy[4];
#pragma unroll
    for (int db = 0; db < 4; ++db) { wx[db] = pk2(O[db][0] * inv, O[db][1] * inv); wy[db] = pk2(O[db][2] * inv, O[db][3] * inv); }
#pragma unroll
    for (int p = 0; p < 2; ++p) {
        auto rx = __builtin_amdgcn_permlane16_swap(wx[2 * p], wx[2 * p + 1], false, false); wx[2 * p] = rx[0]; wx[2 * p + 1] = rx[1];
        auto ry = __builtin_amdgcn_permlane16_swap(wy[2 * p], wy[2 * p + 1], false, false); wy[2 * p] = ry[0]; wy[2 * p + 1] = ry[1]; }
#pragma unroll
    for (int p = 0; p < 2; ++p) {
        auto rx = __builtin_amdgcn_permlane32_swap(wx[p], wx[p + 2], false, false); wx[p] = rx[0]; wx[p + 2] = rx[1];
        auto ry = __builtin_amdgcn_permlane32_swap(wy[p], wy[p + 2], false, false); wy[p] = ry[0]; wy[p + 2] = ry[1]; }
    v4u lo = {wx[0], wy[0], wx[1], wy[1]}, hi = {wx[2], wy[2], wx[3], wy[3]};
    *(v4u*)(yrow + 16 * g) = lo; *(v4u*)(yrow + 16 * g + 8) = hi;
}

constexpr int A_ROWS = 400, A_KOFF = 0, A_VOFF = A_ROWS * 128;
template <bool MASK> __device__ __forceinline__ void a_scores(f32x4& S0, f32x4& S1, float basef, float c1, float slope2, int krow0, int kstart) {
#pragma unroll
    for (int r = 0; r < 4; ++r) {
        const float d0 = fabsf(basef - (float)r), d1 = fabsf(basef - (float)(16 + r));
        const float v0 = S0[r] - slope2 * d0, v1 = S1[r] - slope2 * d1;
        if (MASK) { const int p0 = kstart + krow0 + r, p1 = p0 + 16;
            S0[r] = (d0 <= 128.f && p0 >= 0 && p0 < SEQ) ? v0 : -INFINITY; S1[r] = (d1 <= 128.f && p1 >= 0 && p1 < SEQ) ? v1 : -INFINITY; }
        else { S0[r] = v0; S1[r] = v1; }
    }
}
__device__ __forceinline__ void attn_a_prefetch(const bf16* Z, int unit, v4u (&kr)[7], v4u (&vr)[7]) {
    const int tid = threadIdx.x; const int ib = unit & 63, kvh = (unit >> 6) & 1, b = unit >> 7;
    const size_t tok0 = (size_t)b * SEQ; const int kstart = (ib - 1) * 128;
#pragma unroll
    for (int k = 0; k < 7; ++k) { const int it = tid + k * NTHREADS; const int row = it >> 3, ch = it & 7, pos = kstart + row;
        kr[k] = (v4u){0u, 0u, 0u, 0u}; vr[k] = (v4u){0u, 0u, 0u, 0u};
        if (it < A_ROWS * 8 && row < 384 && pos >= 0 && pos < SEQ) { const int t = (int)tok0 + pos; kr[k] = *(const v4u*)((const unsigned char*)Z + tmo(t, Z_KA / 64 + kvh, ZLD / 64) + ch * 16); vr[k] = *(const v4u*)((const unsigned char*)Z + tmo(t, Z_VA / 64 + kvh, ZLD / 64) + ch * 16); } }
}
__device__ __forceinline__ void attn_a_commit(LAS unsigned char* lds, const v4u (&kr)[7], const v4u (&vr)[7]) {
    const int tid = threadIdx.x; LAS unsigned char* Kl = lds + A_KOFF; LAS unsigned char* Vl = lds + A_VOFF;
#pragma unroll
    for (int k = 0; k < 7; ++k) { const int it = tid + k * NTHREADS; const int row = it >> 3, ch = it & 7;
        if (it < A_ROWS * 8) { *(LAS v4u*)(Kl + swz(row, ch)) = kr[k]; *(LAS v4u*)(Vl + swz(row, ch)) = vr[k]; } }
}
__device__ __forceinline__ void attn_a_unit(LAS unsigned char* lds, const bf16* Z, bf16* Y, const float* sink, int unit) {
    const int tid = threadIdx.x, lane = tid & 63, wid = tid >> 6, lq = lane & 15, g = lane >> 4;
    const int ib = unit & 63, kvh = (unit >> 6) & 1, b = unit >> 7;
    const size_t tok0 = (size_t)b * SEQ; const int kstart = (ib - 1) * 128;
    LAS unsigned char* Kl = lds + A_KOFF; LAS unsigned char* Vl = lds + A_VOFF;
    const int hq = kvh * 4 + (wid >> 1);
    const float slope2 = __builtin_amdgcn_exp2f(-(float)(hq + 1)) * LOG2E, sink2 = sink[hq] * LOG2E, c1 = 0.125f * LOG2E;
    const bool edge = (ib == 0) || (ib == 63);
    for (int bp = 0; bp < 2; ++bp) {
        const int qoffA = (wid & 1) * 64 + bp * 32, qoffB = qoffA + 16;
        const size_t qtokA = tok0 + ib * 128 + qoffA + lq, qtokB = qtokA + 16;
        const unsigned char* qpA = (const unsigned char*)Z + tmo((int)qtokA, Z_QA / 64 + hq, ZLD / 64) + 16 * g; const unsigned char* qpB = qpA + 16 * 128;
        const bf16x8 qA0 = *(const bf16x8*)qpA, qA1 = *(const bf16x8*)(qpA + 64), qB0 = *(const bf16x8*)qpB, qB1 = *(const bf16x8*)(qpB + 64);
        float mA = sink2, lA = (g == 0) ? 1.0f : 0.0f, mB = sink2, lB = lA;
        f32x4 OA[4], OB[4];
#pragma unroll
        for (int d = 0; d < 4; ++d) { OA[d] = (f32x4){0.f, 0.f, 0.f, 0.f}; OB[d] = (f32x4){0.f, 0.f, 0.f, 0.f}; }
        if (edge) {
        for (int st = 0; st < 9; ++st) {
            const int rbA = qoffA + 32 * st, rbB = rbA + 16;
            f32x4 SA0, SA1, SB0, SB1;
            qk_step(Kl, rbA, rbA + 16, lq, g, qA0, qA1, SA0, SA1);
            qk_step(Kl, rbB, rbB + 16, lq, g, qB0, qB1, SB0, SB1);
            const float basef = (float)(128 + lq - 32 * st - 4 * g);
            a_scores<true>(SA0, SA1, basef, c1, slope2, rbA + 4 * g, kstart); a_scores<true>(SB0, SB1, basef, c1, slope2, rbB + 4 * g, kstart);
            softmax_step(SA0, SA1, mA, lA, OA);
            softmax_step(SB0, SB1, mB, lB, OB);
            pv_step(Vl, rbA, rbA + 16, lane, g, SA0, SA1, OA);
            pv_step(Vl, rbB, rbB + 16, lane, g, SB0, SB1, OB);
        }
        } else {
        const LAS unsigned char* kp0 = Kl + swz(qoffA + lq, g); const LAS unsigned char* kp1 = Kl + swz(qoffA + lq, 4 + g);
        const LAS unsigned char* vp[4];
        { const int i = lane & 15, rq4 = i >> 2, p = i & 3;
#pragma unroll
          for (int db = 0; db < 4; ++db) vp[db] = Vl + swz(qoffA + 4 * g + rq4, 2 * db + (p >> 1)) + 8 * (p & 1); }
        float basef = (float)(128 + lq - 4 * g);
#define A_STEP(MASKED, ST) do { f32x4 SA0, SA1, SB0, SB1; \
            qk_at(kp0, kp1, 0, qA0, qA1, SA0, SA1); qk_at(kp0, kp1, 2048, qB0, qB1, SB0, SB1); \
            if (MASKED) { const int rbA_ = qoffA + 32 * (ST); a_scores<true>(SA0, SA1, basef, c1, slope2, rbA_ + 4 * g, kstart); a_scores<true>(SB0, SB1, basef, c1, slope2, rbA_ + 16 + 4 * g, kstart); } \
            else { a_scores<false>(SA0, SA1, basef, c1, slope2, 0, 0); a_scores<false>(SB0, SB1, basef, c1, slope2, 0, 0); } \
            softmax_step(SA0, SA1, mA, lA, OA); softmax_step(SB0, SB1, mB, lB, OB); \
            pv_at(vp, 0, SA0, SA1, OA); pv_at(vp, 2048, SB0, SB1, OB); \
            kp0 += 4096; kp1 += 4096; basef -= 32.f; _Pragma("unroll") for (int db_ = 0; db_ < 4; ++db_) vp[db_] += 4096; } while (0)
        A_STEP(true, 0);
        for (int st = 1; st < 8; ++st) A_STEP(false, st);
        A_STEP(true, 8);
#undef A_STEP
        }
        store_o((bf16*)((unsigned char*)Y + tmo((int)qtokA, hq, 16)), g, lA, OA);
        store_o((bf16*)((unsigned char*)Y + tmo((int)qtokB, hq, 16)), g, lB, OB);
    }
}
constexpr int B_ROWS = 9 * 64, B_KOFF = 0, B_VOFF = B_ROWS * 128, B_TOFF = 2 * B_ROWS * 128, B_TREAL = 544, B_TSIZE = 800;
static_assert(B_TOFF + B_TSIZE * 4 <= LDS_BYTES && A_VOFF + A_ROWS * 128 <= LDS_BYTES, "LDS map");
__device__ __forceinline__ int clampi(int v, int lo, int hi) { return v < lo ? lo : (v > hi ? hi : v); }
__device__ __forceinline__ void attn_b_prefetch(const bf16* Z, const float* rpb, int unit, v4u (&kr)[9], v4u (&vr)[9], float (&tr)[2]) {
    const int tid = threadIdx.x; const int rp = unit & 63, h = (unit >> 6) & 7, b = unit >> 9;
    const size_t tok0 = (size_t)b * SEQ; const int R0 = clampi(2 * rp - 4, 0, 120);
#pragma unroll
    for (int k = 0; k < 9; ++k) { const int it = tid + k * NTHREADS; const int row = it >> 3, ch = it & 7, gr = R0 + (row >> 6);
        kr[k] = (v4u){0u, 0u, 0u, 0u}; vr[k] = (v4u){0u, 0u, 0u, 0u};
        if (gr < 128) { const int t = (int)tok0 + gr * 64 + (row & 63); kr[k] = *(const v4u*)((const unsigned char*)Z + tmo(t, Z_KB / 64 + h, ZLD / 64) + ch * 16); vr[k] = *(const v4u*)((const unsigned char*)Z + tmo(t, Z_VB / 64 + h, ZLD / 64) + ch * 16); } }
#pragma unroll
    for (int k = 0; k < 2; ++k) { const int it = tid + k * NTHREADS, e = it - 16, dr = e >> 5, dc = e & 31;
        tr[k] = (it >= B_TREAL) ? -INFINITY : ((e >= 0 && dr < 15 && dc < 31) ? rpb[h * 465 + dr * 31 + dc] * LOG2E : 0.f); }
}
__device__ __forceinline__ void attn_b_commit(LAS unsigned char* lds, const v4u (&kr)[9], const v4u (&vr)[9], const float (&tr)[2]) {
    const int tid = threadIdx.x; LAS unsigned char* Kl = lds + B_KOFF; LAS unsigned char* Vl = lds + B_VOFF; LAS float* T = (LAS float*)(lds + B_TOFF);
#pragma unroll
    for (int k = 0; k < 9; ++k) { const int it = tid + k * NTHREADS; const int row = it >> 3, ch = it & 7;
        *(LAS v4u*)(Kl + swz(row, ch)) = kr[k]; *(LAS v4u*)(Vl + swz(row, ch)) = vr[k]; }
#pragma unroll
    for (int k = 0; k < 2; ++k) { const int it = tid + k * NTHREADS; if (it < B_TSIZE) T[it] = tr[k]; }
}
__device__ __forceinline__ void attn_b_unit(LAS unsigned char* lds, const bf16* Z, bf16* Y, int unit) {
    const int tid = threadIdx.x, lane = tid & 63, wid = tid >> 6, lq = lane & 15, g = lane >> 4;
    const int rp = unit & 63, h = (unit >> 6) & 7, b = unit >> 9;
    const size_t tok0 = (size_t)b * SEQ;
    const int R0 = clampi(2 * rp - 4, 0, 120);
    LAS unsigned char* Kl = lds + B_KOFF; LAS unsigned char* Vl = lds + B_VOFF; LAS float* T = (LAS float*)(lds + B_TOFF);
    const int rq = 2 * rp + (wid >> 2), cb = wid & 3, c = 16 * cb + lq;
    const int r0q = clampi(rq - 4, 0, 120), kc0 = clampi(16 * cb - 8, 0, 32), cs = clampi(c - 8, 0, 48);
    const size_t qtok = tok0 + (size_t)rq * 64 + c;
    const unsigned char* qp = (const unsigned char*)Z + tmo((int)qtok, Z_QB / 64 + h, ZLD / 64) + 16 * g;
    const bf16x8 qf0 = *(const bf16x8*)qp, qf1 = *(const bf16x8*)(qp + 64);
    float m0 = -1e30f, l0 = 0.f, m1 = -1e30f, l1 = 0.f;
    f32x4 O0[4], O1[4];
#pragma unroll
    for (int d = 0; d < 4; ++d) { O0[d] = (f32x4){0.f, 0.f, 0.f, 0.f}; O1[d] = (f32x4){0.f, 0.f, 0.f, 0.f}; }
    const int kcl = kc0 + 4 * g;
    const int tb = 16 + (kcl - c + 15);
    const int Rb = (r0q - R0) * 64 + kc0;
    const LAS unsigned char* kp0 = Kl + swz(Rb + lq, g); const LAS unsigned char* kp1 = Kl + swz(Rb + lq, 4 + g);
    const LAS unsigned char* vp[4];
    { const int i = lane & 15, rq4 = i >> 2, p = i & 3;
#pragma unroll
      for (int db = 0; db < 4; ++db) vp[db] = Vl + swz(Rb + 4 * g + rq4, 2 * db + (p >> 1)) + 8 * (p & 1); }
    const LAS float* T0 = T + tb + (r0q - rq + 7) * 32;
    const LAS float* tpa[4]; const LAS float* tpb[4];
#pragma unroll
    for (int r = 0; r < 4; ++r) { const int kca = kcl + r, kcb = kca + 16;
        tpa[r] = (kca >= cs && kca <= cs + 15) ? T0 + r : T + B_TREAL; tpb[r] = (kcb >= cs && kcb <= cs + 15) ? T0 + 16 + r : T + B_TREAL; }
#pragma unroll
    for (int st = 0; st < 4; ++st) {
        const int offA = st * 8192, offB = offA + 4 * 8192;
        f32x4 SA0, SA1, SB0, SB1;
        qk_at(kp0, kp1, offA, qf0, qf1, SA0, SA1);
        qk_at(kp0, kp1, offB, qf0, qf1, SB0, SB1);
#pragma unroll
        for (int r = 0; r < 4; ++r) {
            SA0[r] += tpa[r][st * 32]; SA1[r] += tpb[r][st * 32]; SB0[r] += tpa[r][st * 32 + 128]; SB1[r] += tpb[r][st * 32 + 128];
        }
        softmax_step(SA0, SA1, m0, l0, O0);
        softmax_step(SB0, SB1, m1, l1, O1);
        pv_at(vp, offA, SA0, SA1, O0);
        pv_at(vp, offB, SB0, SB1, O1);
    }
    { const float mm = fmaxf(m0, m1), a0 = __builtin_amdgcn_exp2f(m0 - mm), a1 = __builtin_amdgcn_exp2f(m1 - mm);
      l0 = l0 * a0 + l1 * a1;
#pragma unroll
      for (int d = 0; d < 4; ++d) O0[d] = O0[d] * a0 + O1[d] * a1; }
    store_o((bf16*)((unsigned char*)Y + tmo((int)qtok, 8 + h, 16)), g, l0, O0);
}

#define XB_TMO      128
#define XB_XCNT(j)  (256  + 64 * (j))
#define XB_XSUB(j)  (1280 + 64 * (j))
#define XB_XGEN(j)  (2304 + 64 * (j))
#define XB_TOP      3328
#define XB_TOPGEN   3392
#define XCD_BAR_WORDS 3456
#define XB_SPIN_CAP (1u << 18)

__device__ __forceinline__ unsigned xb_ld(unsigned* p)              { return __hip_atomic_load(p, __ATOMIC_RELAXED, __HIP_MEMORY_SCOPE_AGENT); }
__device__ __forceinline__ unsigned xb_add(unsigned* p, unsigned v) { return __hip_atomic_fetch_add(p, v, __ATOMIC_RELAXED, __HIP_MEMORY_SCOPE_AGENT); }
__device__ __forceinline__ unsigned xb_xcc_id() { return (unsigned)__builtin_amdgcn_s_getreg((3 << 11) | 20) & 0xFu; }
#define XB_SPIN(cond, bar) do { unsigned _sp = 0; while (cond) { __builtin_amdgcn_s_sleep(1); \
    if ((++_sp & 255u) == 0u) { if (xb_ld(&(bar)[XB_TMO])) break; if (_sp > XB_SPIN_CAP) { atomicAdd(&(bar)[XB_TMO], 1u); break; } } } } while (0)

struct XcdBarrier {
    unsigned* bar; unsigned x;
    volatile LAS unsigned* st;
};

__device__ __forceinline__ XcdBarrier xcd_barrier_post(unsigned* bar, volatile LAS unsigned* st) {
    XcdBarrier b; b.bar = bar; b.x = xb_xcc_id(); b.st = st;
    if (threadIdx.x == 0) (void)xb_add(&bar[XB_XCNT(b.x)], 1u);
    return b;
}
__device__ __forceinline__ void xcd_barrier_complete(unsigned* bar, unsigned x, unsigned& nloc, unsigned& nx) {
    const unsigned G = gridDim.x * gridDim.y * gridDim.z;
    unsigned sum, cnt, mine, sp = 0u;
    for (;;) {
        sum = 0u; cnt = 0u; mine = 0u;
#pragma unroll
        for (unsigned j = 0; j < 16; ++j) { const unsigned c = xb_ld(&bar[XB_XCNT(j)]); sum += c; cnt += (c > 0u) ? 1u : 0u; mine = (j == x) ? c : mine; }
        if (sum == G) break;
        __builtin_amdgcn_s_sleep(1);
        if ((++sp & 255u) == 0u) { if (xb_ld(&bar[XB_TMO])) break; if (sp > XB_SPIN_CAP) { atomicAdd(&bar[XB_TMO], 1u); break; } }
    }
    nloc = mine > 0u ? mine : 1u; nx = cnt > 0u ? cnt : 1u;
}

__device__ __forceinline__ void xcd_barrier(const XcdBarrier& b) {
    asm volatile("s_waitcnt vmcnt(0)" ::: "memory");
    __syncthreads();
    if (threadIdx.x == 0) {
        unsigned* bar = b.bar;
        __builtin_amdgcn_s_waitcnt(0);
        unsigned nloc = b.st[0], nx = b.st[1];
        if (nloc == 0u) { xcd_barrier_complete(bar, b.x, nloc, nx); b.st[0] = nloc; b.st[1] = nx; }
        const unsigned old = xb_add(&bar[XB_XSUB(b.x)], 1u);
        const unsigned gen = old / nloc;
        if (old + 1u == (gen + 1u) * nloc) {
            __builtin_amdgcn_fence(__ATOMIC_RELEASE, "agent");
            asm volatile("s_waitcnt vmcnt(0)" ::: "memory");
            const unsigned og = xb_add(&bar[XB_TOP], 1u);
            const unsigned tg = og / nx;
            if (og + 1u == (tg + 1u) * nx) xb_add(&bar[XB_TOPGEN], 1u);
            else XB_SPIN(xb_ld(&bar[XB_TOPGEN]) == tg, bar);
            __builtin_amdgcn_fence(__ATOMIC_ACQUIRE, "agent");
            xb_add(&bar[XB_XGEN(b.x)], 1u);
            asm volatile("s_waitcnt vmcnt(0)" ::: "memory");
        } else {
            XB_SPIN(xb_ld(&bar[XB_XGEN(b.x)]) == gen, bar);
            __builtin_amdgcn_fence(__ATOMIC_ACQUIRE, "agent");
            asm volatile("s_waitcnt vmcnt(0)" ::: "memory");
        }
    }
    __syncthreads();
}

struct Args { const float* in[13]; float* out; unsigned char* ws; int ph_lo, ph_hi; };
constexpr int N_PHASES = 8;
__global__ void __launch_bounds__(NTHREADS, 2) mk_fwd(Args args) {
    extern __shared__ __attribute__((aligned(16))) unsigned char lds_raw[];
    LAS unsigned char* lds = (LAS unsigned char*)lds_raw;
    const int tid = threadIdx.x, lane = tid & 63, wave = __builtin_amdgcn_readfirstlane(tid >> 6);
    const int G = gridDim.x, bx = blockIdx.x;
    const int vcu = (G % 8 == 0) ? (bx % 8) * (G / 8) + bx / 8 : bx;
    unsigned char* ws = args.ws;
    const float* x = args.in[0]; const float* norm_mix = args.in[1]; const float* w_in = args.in[2]; const float* b_gate = args.in[3];
    const float* sink = args.in[4]; const float* rpb = args.in[5]; const float* w_pa = args.in[6]; const float* w_pb = args.in[7];
    const float* w_out = args.in[8]; const float* norm_mlp = args.in[9]; const float* w_up = args.in[10]; const float* w_dn = args.in[11]; const float* norm_final = args.in[12];
    float* out = args.out;
    float* ss1 = (float*)(ws + WS_SS1); float* ss2 = (float*)(ws + WS_SS2); unsigned* cnt6 = (unsigned*)(ws + WS_CNT);
    bf16 *Win_t = (bf16*)(ws + WS_WIN), *Wpa_t = (bf16*)(ws + WS_WPA), *Wpb_t = (bf16*)(ws + WS_WPB), *Wout_t = (bf16*)(ws + WS_WOUT), *Wup_t = (bf16*)(ws + WS_WUP), *Wdn_t = (bf16*)(ws + WS_WDN);
    bf16 *XN = (bf16*)(ws + WS_XN), *YA = (bf16*)(ws + WS_YA), *YB = (bf16*)(ws + WS_YB), *MG = (bf16*)(ws + WS_MG), *X2 = (bf16*)(ws + WS_X2), *Zb = (bf16*)(ws + WS_Z), *Hb = (bf16*)(ws + WS_Z);
    const int lo = args.ph_lo, hi = args.ph_hi;
    volatile LAS unsigned* bst = (volatile LAS unsigned*)(lds + LDS_BYTES - 16);
    if (tid < 4) bst[tid] = 0u;
    __syncthreads();
    XcdBarrier bar = xcd_barrier_post((unsigned*)(ws + WS_BAR), bst);
#define IN(k) (lo <= (k) && (k) < hi)
#define SEAM(k) do { if (IN(k) && IN((k) + 1)) { if (hi > N_PHASES) cg::this_grid().sync(); else xcd_barrier(bar); } } while (0)

    if (IN(0)) {
        LAS float* scr = (LAS float*)(lds + wave * 16384);
        const int gw = vcu * NWAVES + wave, NGW = G * NWAVES;
        constexpr int I_IN = (DM / 64) * (ZLD / 32), I_P = (512 / 64) * (DM / 32), I_O = (DM / 64) * (DM / 32), I_U = (DM / 64) * (FF / 32), I_D = (FF / 64) * (DM / 32);
        constexpr int NITEMS = I_IN + 2 * I_P + I_O + I_U + I_D;
        for (int it = gw; it < NITEMS; it += NGW) {
            int r = it;
            if (r < I_IN) { p0_transpose_item(w_in, DM, ZLD, Win_t, scr, r, lane); continue; } r -= I_IN;
            if (r < I_P) { p0_transpose_item(w_pa, 512, DM, Wpa_t, scr, r, lane, nullptr, 1024, 0); continue; } r -= I_P;
            if (r < I_P) { p0_transpose_item(w_pb, 512, DM, Wpa_t, scr, r, lane, nullptr, 1024, 512); continue; } r -= I_P;
            if (r < I_O) { p0_transpose_item(w_out, DM, DM, Wout_t, scr, r, lane); continue; } r -= I_O;
            if (r < I_U) { p0_transpose_item(w_up, DM, FF, Wup_t, scr, r, lane, norm_mlp); continue; } r -= I_U;
            p0_transpose_item(w_dn, FF, DM, Wdn_t, scr, r, lane);
        }
        for (int i = bx * NTHREADS + tid; i < M; i += G * NTHREADS) { ss1[i] = 0.f; ss2[i] = 0.f; if (i < 256 * 16) cnt6[i] = 0u; }
        {
            const f32x4* gr = (const f32x4*)norm_mix + lane; f32x4 gg[4];
#pragma unroll
            for (int j = 0; j < 4; ++j) gg[j] = gr[64 * j];
            for (int mrow = gw; mrow < M; mrow += 4 * NGW) {
                f32x4 v[4][4]; float ssq[4];
#pragma unroll
                for (int r = 0; r < 4; ++r) { const f32x4* xr = (const f32x4*)(x + (size_t)min(mrow + r * NGW, M - 1) * DM) + lane;
#pragma unroll
                    for (int j = 0; j < 4; ++j) v[r][j] = __builtin_nontemporal_load(xr + 64 * j); }
#pragma unroll
                for (int r = 0; r < 4; ++r) { float t = 0.f;
#pragma unroll
                    for (int j = 0; j < 4; ++j) t += (v[r][j].x * v[r][j].x + v[r][j].y * v[r][j].y) + (v[r][j].z * v[r][j].z + v[r][j].w * v[r][j].w);
                    ssq[r] = t; }
#pragma unroll
                for (int o = 1; o < 64; o <<= 1) {
#pragma unroll
                    for (int r = 0; r < 4; ++r) ssq[r] += __shfl_xor(ssq[r], o); }
#pragma unroll
                for (int r = 0; r < 4; ++r) { const float rstd = 1.0f / sqrtf(ssq[r] * (1.f / DM) + EPS);
                    unsigned char* o8 = (unsigned char*)XN + tmo(min(mrow + r * NGW, M - 1), lane >> 4, 16) + 8 * (lane & 15);
#pragma unroll
                    for (int j = 0; j < 4; ++j) { const f32x4 t = v[r][j] * rstd * gg[j]; *(unsigned long long*)(o8 + (size_t)j * 4 * 32768) = (unsigned long long)pk2(t.x, t.y) | ((unsigned long long)pk2(t.z, t.w) << 32); } }
            }
        }
        __syncthreads();
    }
    SEAM(0);
    if (IN(1)) {
        pg8::Gemm g{XN, Win_t, M, ZLD, DM}; pg8::StaticOrder S; S.init(M, ZLD, G, bx);
        pg8::EpiPlain E{Zb, ZLD / 64, lds + 131072};
        pg8::gemm_phase<pg8::EpiPlain, pg8::StaticOrder, PG8_ALIGN, PG8_SP2>(lds, g, S, E);
    }
    SEAM(1);
    if (IN(2)) {
        {
            v4u kr[7], vr[7]; int u = vcu; const int NU = BATCH * 2 * 64;
            if (u < NU) attn_a_prefetch(Zb, u, kr, vr);
            for (; u < NU; u += G) {
                attn_a_commit(lds, kr, vr);
                __syncthreads();
                if (u + G < NU) attn_a_prefetch(Zb, u + G, kr, vr);
                asm volatile("" ::: "memory");
                attn_a_unit(lds, Zb, YA, sink, u);
                __syncthreads();
            }
        }
        {
            v4u kr[9], vr[9]; float tr[2]; int u = vcu; const int NU = BATCH * 8 * 64;
            if (u < NU) attn_b_prefetch(Zb, rpb, u, kr, vr, tr);
            for (; u < NU; u += G) {
                attn_b_commit(lds, kr, vr, tr);
                __syncthreads();
                if (u + G < NU) attn_b_prefetch(Zb, rpb, u + G, kr, vr, tr);
                asm volatile("" ::: "memory");
                attn_b_unit(lds, Zb, YA, u);
                __syncthreads();
            }
        }
    }
    SEAM(2);
    if (IN(3)) {
        pg8::Gemm g{YA, Wpa_t, M, DM, DM}; pg8::StaticOrder S; S.init(M, DM, G, bx);
        pg8::EpiGate2 E{MG, Zb, ZLD / 64, Z_GA / 64, Z_GB / 64, b_gate, lds + 131072};
        pg8::gemm_phase<pg8::EpiGate2, pg8::StaticOrder, PG8_ALIGN, PG8_SP2>(lds, g, S, E);
    }
    SEAM(3);
    if (IN(4)) {
        pg8::Gemm g{MG, Wout_t, M, DM, DM}; pg8::StaticOrder S; S.init(M, DM, G, bx);
        pg8::EpiRes1 E{x, XN, ss1, lds + 131072};
        pg8::gemm_phase<pg8::EpiRes1, pg8::StaticOrder, PG8_ALIGN, PG8_SP2>(lds, g, S, E);
    }
    SEAM(4);
    if (IN(5)) {
        pg8::Gemm g{XN, Wup_t, M, FF, DM}; pg8::StaticOrder S; S.init(M, FF, G, bx);
        pg8::EpiUp E{Hb, ss1, EPS, lds + 131072};
        pg8::gemm_phase<pg8::EpiUp, pg8::StaticOrder, PG8_ALIGN, PG8_SP2>(lds, g, S, E);
    }
    SEAM(5);
    if (IN(6)) {
        pg8::Gemm g{Hb, Wdn_t, M, DM, FF}; pg8::StaticOrder S; S.init(M, DM, G, bx);
        if (G == 256 && hi == N_PHASES && PG8_ALIGN) { pg8::EpiResNorm E{XN, out, norm_final, ss2, cnt6, EPS, lds + 131072};
            pg8::gemm_phase<pg8::EpiResNorm, pg8::StaticOrder, PG8_ALIGN, PG8_SP2>(lds, g, S, E); }
        else { pg8::EpiRes2 E{XN, X2, ss2, lds + 131072};
            pg8::gemm_phase<pg8::EpiRes2, pg8::StaticOrder, PG8_ALIGN, PG8_SP2>(lds, g, S, E); }
    }
    const bool fusedNorm = (G == 256 && hi == N_PHASES && PG8_ALIGN);
    if (!fusedNorm) SEAM(6);
    if (IN(7) && !fusedNorm) {
        const int gw = vcu * NWAVES + wave, NGW = G * NWAVES;
        const f32x4* gr = (const f32x4*)norm_final + lane;
        f32x4 gg[4];
#pragma unroll
        for (int j = 0; j < 4; ++j) gg[j] = gr[64 * j];
        for (int mrow = 4 * gw; mrow < M; mrow += 4 * NGW) {
            v2u xv[4][4]; float rstd[4];
#pragma unroll
            for (int r = 0; r < 4; ++r) { const unsigned char* xr = (const unsigned char*)X2 + tmo(mrow + r, lane >> 4, 16) + 8 * (lane & 15);
                rstd[r] = __hip_atomic_load(ss2 + mrow + r, __ATOMIC_RELAXED, __HIP_MEMORY_SCOPE_AGENT);
#pragma unroll
                for (int j = 0; j < 4; ++j) xv[r][j] = __builtin_nontemporal_load((const v2u*)(xr + (size_t)j * 4 * 32768)); }
#pragma unroll
            for (int r = 0; r < 4; ++r) { const float rs = 1.0f / sqrtf(rstd[r] * (1.f / DM) + EPS); f32x4* orow = (f32x4*)(out + (size_t)(mrow + r) * DM) + lane;
#pragma unroll
                for (int j = 0; j < 4; ++j) { const f32x4 v = {__uint_as_float(xv[r][j].x << 16), __uint_as_float(xv[r][j].x & 0xffff0000u), __uint_as_float(xv[r][j].y << 16), __uint_as_float(xv[r][j].y & 0xffff0000u)};
                    __builtin_nontemporal_store(v * rs * gg[j], orow + 64 * j); } }
        }
    }
#undef IN
#undef SEAM
}

extern "C" void kernel_launch(void* const* d_in, const int* in_sizes, int n_in, void* d_out, int out_size, void* d_ws, size_t ws_size, hipStream_t stream) {
    static int grid = 0;
    if (grid == 0) {
        if (n_in != 13 || in_sizes[0] != M * DM || out_size != M * DM || ws_size < WS_END) { fprintf(stderr, "kernel_launch: unexpected shapes (n_in %d in0 %d out %d ws %zu)\n", n_in, n_in > 0 ? in_sizes[0] : -1, out_size, ws_size); grid = -1; return; }
        int dev = 0, cus = 0, per_cu = 0;
        if (hipGetDevice(&dev) != hipSuccess || hipDeviceGetAttribute(&cus, hipDeviceAttributeMultiprocessorCount, dev) != hipSuccess) { grid = -1; return; }
        if (hipFuncSetAttribute((const void*)mk_fwd, hipFuncAttributeMaxDynamicSharedMemorySize, LDS_BYTES) != hipSuccess) { fprintf(stderr, "kernel_launch: hipFuncSetAttribute failed\n"); grid = -1; return; }
        if (hipOccupancyMaxActiveBlocksPerMultiprocessor(&per_cu, (const void*)mk_fwd, NTHREADS, LDS_BYTES) != hipSuccess || per_cu < 1) { fprintf(stderr, "kernel_launch: occupancy query says %d\n", per_cu); per_cu = 1; }
        (void)hipGetLastError();
        grid = cus * per_cu;
    }
    if (grid < 0) return;
    if (hipMemsetAsync((char*)d_ws + WS_BAR, 0, WS_BAR_BYTES, stream) != hipSuccess) { fprintf(stderr, "kernel_launch: hipMemsetAsync failed\n"); return; }
    Args a{};
    for (int i = 0; i < 13; ++i) a.in[i] = (const float*)d_in[i];
    a.out = (float*)d_out; a.ws = (unsigned char*)d_ws;
#if MK_MULTI
    for (int p = 0; p < N_PHASES; ++p) { a.ph_lo = p; a.ph_hi = p + 1; hipLaunchKernelGGL(mk_fwd, dim3(grid), dim3(NTHREADS), LDS_BYTES, stream, a); }
#else
    a.ph_lo = 0; a.ph_hi = N_PHASES;
    void* kargs[] = {&a};
    hipError_t e = hipLaunchCooperativeKernel((const void*)mk_fwd, dim3(grid), dim3(NTHREADS), kargs, LDS_BYTES, stream);
    if (e != hipSuccess) fprintf(stderr, "cooperative launch failed: %s (grid %d)\n", hipGetErrorString(e), grid);
#endif
}
```

```cpp
#include <hip/hip_runtime.h>
#include <hip/hip_cooperative_groups.h>
#include <cstdio>
#include <cstdint>
namespace cg = cooperative_groups;
namespace pg8 {
#define PG8_LAS __attribute__((address_space(3)))
typedef unsigned short bf16_t;
typedef short bf16x8 __attribute__((ext_vector_type(8)));
typedef float f32x4 __attribute__((ext_vector_type(4)));
typedef unsigned u32x4 __attribute__((ext_vector_type(4)));
constexpr int BM = 256, BK = 64, HALF = 128, HTB = HALF * BK * 2  , STAGE_BYTES = 8 * HTB, NXCD = 8, WGM = 8;

__host__ __device__ __forceinline__ int lds_byte(int r, int c) { const int st = (r >> 4) * 2 + (c >> 5), rr = r & 15, cc = c & 31, ob = rr * 64 + cc * 2; return st * 1024 + (ob ^ (((ob >> 9) & 1) << 5)); }
__host__ __device__ __forceinline__ void stage_rc(int b, int& R, int& C) { const int st = b / 1024, sb = b % 1024, swz = sb ^ (((sb >> 9) & 1) << 5); R = (st >> 1) * 16 + swz / 64; C = (st & 1) * 32 + (swz % 64) / 2; }
__host__ __device__ __forceinline__ int perm32(int rho) { const int n = rho >> 4, i = rho & 15; return 8 * (i >> 2) + 4 * n + (i & 3); }

struct Unit { int pm, pn; };
struct Gemm { const bf16_t* A; const bf16_t* Bt; int M, N, K; };

struct StaticOrder {
    int nM, nN, nwg, G, c;
    __host__ __device__ void init(int M, int N, int G_, int c_) { nM = M / BM; nN = N / BM; nwg = nM * nN; G = G_; c = c_; }
    __host__ __device__ bool next(int i, Unit& u) const {
        const long L = (long)i * G + c; if (L >= nwg) return false;
        int wgid = (int)L; { const int q = nwg / NXCD, r = nwg % NXCD, xcd = wgid % NXCD, off = wgid / NXCD; wgid = (xcd < r ? xcd * (q + 1) : r * (q + 1) + (xcd - r) * q) + off; }
        const int nig = WGM * nN, gid = wgid / nig, fm = gid * WGM, gsz = (nM - fm) < WGM ? (nM - fm) : WGM;
        u.pm = fm + ((wgid % nig) % gsz); u.pn = (wgid % nig) / gsz; return true;
    }
    __device__ __forceinline__ void a_ready(const Unit&) const {}
    __device__ __forceinline__ void done(const Unit&) const {}
};

__device__ __forceinline__ unsigned cvt_pk_bf16(float lo, float hi) { unsigned r; asm volatile("v_cvt_pk_bf16_f32 %0, %1, %2" : "=v"(r) : "v"(lo), "v"(hi)); return r; }
typedef float f32x2 __attribute__((ext_vector_type(2)));
typedef unsigned u32x2 __attribute__((ext_vector_type(2)));
__device__ __forceinline__ float bf_lo(unsigned w) { return __uint_as_float(w << 16); }
__device__ __forceinline__ float bf_hi(unsigned w) { return __uint_as_float(w & 0xffff0000u); }
__device__ __forceinline__ size_t tm_block(int pm, int ct, int nct) { return ((size_t)pm * nct + ct) * 32768; }
__device__ __forceinline__ int tm_lane(int wr, int fr, int fq) { return (wr * 64 + fr) * 128 + fq * 16; }
#define TM_PIECE(ai, m, bj) ((ai) * 16384 + (m) * 2048 + (bj) * 64)
__device__ __forceinline__ u32x4 pack8(const f32x4& v0, const f32x4& v1) { u32x4 w; w.x = cvt_pk_bf16(v0[0], v0[1]); w.y = cvt_pk_bf16(v0[2], v0[3]); w.z = cvt_pk_bf16(v1[0], v1[1]); w.w = cvt_pk_bf16(v1[2], v1[3]); return w; }
#define UNPK0(q_) ((f32x4){bf_lo((q_).x), bf_hi((q_).x), bf_lo((q_).y), bf_hi((q_).y)})
#define UNPK1(q_) ((f32x4){bf_lo((q_).z), bf_hi((q_).z), bf_lo((q_).w), bf_hi((q_).w)})

#define PG8_SCR_STRIDE 144
#define PG8_SCR_WAVE 2304
struct PieceOut { PG8_LAS unsigned char* wp; const PG8_LAS unsigned char* rp; unsigned char* ob;
    __device__ __forceinline__ PieceOut(PG8_LAS unsigned char* scr, void* O, size_t block, int wr, int wc, int fr, int fq) {
        const int lane = fq * 16 + fr; PG8_LAS unsigned char* my = scr + (wr * 4 + wc) * PG8_SCR_WAVE;
        wp = my + fr * PG8_SCR_STRIDE + fq * 16; rp = my + (lane >> 3) * PG8_SCR_STRIDE + (lane & 7) * 16; ob = (unsigned char*)O + block + (size_t)(wr * 64) * 128 + lane * 16; }
    __device__ __forceinline__ void put(int bj, const u32x4& w) const { *(PG8_LAS u32x4*)(wp + bj * 64) = w; }
    template <bool NT> __device__ __forceinline__ void flush(int ai, int m) const {
        const u32x4 r0 = *(const PG8_LAS u32x4*)rp, r1 = *(const PG8_LAS u32x4*)(rp + 8 * PG8_SCR_STRIDE);
        u32x4* p = (u32x4*)(ob + ai * 16384 + m * 2048);
        if (NT) { __builtin_nontemporal_store(r0, p); __builtin_nontemporal_store(r1, p + 64); } else { *p = r0; *(p + 64) = r1; } }
};
struct PieceIn { PG8_LAS unsigned char* wp; PG8_LAS unsigned char* rp; const unsigned char* ib;
    __device__ __forceinline__ PieceIn(PG8_LAS unsigned char* scr, const void* I, size_t block, int wr, int wc, int fr, int fq) {
        const int lane = fq * 16 + fr; PG8_LAS unsigned char* my = scr + (wr * 4 + wc) * PG8_SCR_WAVE;
        wp = my + fr * PG8_SCR_STRIDE + fq * 16; rp = my + (lane >> 3) * PG8_SCR_STRIDE + (lane & 7) * 16; ib = (const unsigned char*)I + block + (size_t)(wr * 64) * 128 + lane * 16; }
    __device__ __forceinline__ void fetch(int ai, int m, u32x4& raw0, u32x4& raw1) const { const u32x4* p = (const u32x4*)(ib + ai * 16384 + m * 2048); raw0 = *p; raw1 = *(p + 64); }
    __device__ __forceinline__ void stage(const u32x4& raw0, const u32x4& raw1) const { *(PG8_LAS u32x4*)rp = raw0; *(PG8_LAS u32x4*)(rp + 8 * PG8_SCR_STRIDE) = raw1; }
    __device__ __forceinline__ u32x4 get(int bj) const { return *(const PG8_LAS u32x4*)(wp + bj * 64); }
};
struct EpiPlain {
    static constexpr bool PERM = true, AFTER_DRAIN = false, HAS_MID = false, HAS_PRE = false;
    bf16_t* O; int nct; PG8_LAS unsigned char* scr;
    __device__ __forceinline__ void operator()(const f32x4 (&acc)[2][2][4][2], const Unit& u, int wr, int wc, int fr, int fq) const {
        const PieceOut po(scr, O, tm_block(u.pm, u.pn * 4 + wc, nct), wr, wc, fr, fq);
        const float qs = (u.pn < 2 || u.pn == 3 || u.pn == 4) ? 0.125f * 1.4426950408889634f : 1.0f;
#pragma unroll
        for (int ai = 0; ai < 2; ++ai)
#pragma unroll
            for (int m = 0; m < 4; ++m) { po.put(0, pack8(acc[ai][0][m][0] * qs, acc[ai][0][m][1] * qs)); po.put(1, pack8(acc[ai][1][m][0] * qs, acc[ai][1][m][1] * qs)); po.flush<true>(ai, m); }
    }
};
struct EpiGate2 {
    static constexpr bool PERM = true, AFTER_DRAIN = false, HAS_MID = true, HAS_PRE = false;
    bf16_t* O; const bf16_t* Z; int znct; int ga_ct, gb_ct; const float* bg; PG8_LAS unsigned char* scr;
    static __device__ __forceinline__ float eneg(float g) { return __builtin_amdgcn_exp2f(-1.4426950408889634f * fminf(fmaxf(g, -30.f), 30.f)); }
    __device__ __forceinline__ void mid(f32x4 (&acc)[2][2][4][2], const Unit& u, int wr, int wc, int fr, int fq) const {
        int pm = u.pm, cb = u.pn * 4 + wc;
        asm volatile("" : "+v"(pm), "+v"(cb));
        const PieceIn pa(scr, Z, tm_block(pm, ga_ct + cb, znct), wr, wc, fr, fq), pb(scr, Z, tm_block(pm, gb_ct + cb, znct), wr, wc, fr, fq);
        const int col0 = cb * 64 + 8 * fq;
        f32x4 ba[2][2], bb[2][2];
#pragma unroll
        for (int bj = 0; bj < 2; ++bj) { ba[bj][0] = *(const f32x4*)(bg + col0 + bj * 32); ba[bj][1] = *(const f32x4*)(bg + col0 + bj * 32 + 4); bb[bj][0] = *(const f32x4*)(bg + 1024 + col0 + bj * 32); bb[bj][1] = *(const f32x4*)(bg + 1024 + col0 + bj * 32 + 4); }
#pragma unroll
        for (int am = 0; am < 4; ++am) { const int ai = am >> 1;
            u32x4 ra[4][2], rb[4][2];
#pragma unroll
            for (int m = 2 * (am & 1); m < 2 * (am & 1) + 2; ++m) { pa.fetch(ai, m, ra[m][0], ra[m][1]); pb.fetch(ai, m, rb[m][0], rb[m][1]); }
            asm volatile("" ::: "memory");
#pragma unroll
            for (int m = 2 * (am & 1); m < 2 * (am & 1) + 2; ++m) {
                pa.stage(ra[m][0], ra[m][1]); const u32x4 ga0 = pa.get(0), ga1 = pa.get(1);
                asm volatile("" ::: "memory");
                pb.stage(rb[m][0], rb[m][1]); const u32x4 gb0 = pb.get(0), gb1 = pb.get(1);
                asm volatile("" ::: "memory");
#pragma unroll
                for (int bj = 0; bj < 2; ++bj) { const u32x4 ga = bj ? ga1 : ga0, gb = bj ? gb1 : gb0;
                    const f32x4 a0 = UNPK0(ga) + ba[bj][0], a1 = UNPK1(ga) + ba[bj][1], b0 = UNPK0(gb) + bb[bj][0], b1 = UNPK1(gb) + bb[bj][1];
#pragma unroll
                    for (int k = 0; k < 4; ++k) { acc[ai][bj][m][0][k] *= (1.0f + eneg(b0[k])) * __builtin_amdgcn_rcpf(1.0f + eneg(a0[k]));
                                                  acc[ai][bj][m][1][k] *= (1.0f + eneg(b1[k])) * __builtin_amdgcn_rcpf(1.0f + eneg(a1[k])); } } }
        }
    }
    __device__ __forceinline__ void operator()(const f32x4 (&acc)[2][2][4][2], const Unit& u, int wr, int wc, int fr, int fq) const {
        const int cb = u.pn * 4 + wc, col0 = cb * 64 + 8 * fq;
        const PieceOut po(scr, O, tm_block(u.pm, cb, 16), wr, wc, fr, fq);
        const PieceIn pb(scr, Z, tm_block(u.pm, gb_ct + cb, znct), wr, wc, fr, fq);
        f32x4 bb[2][2];
#pragma unroll
        for (int bj = 0; bj < 2; ++bj) { bb[bj][0] = *(const f32x4*)(bg + 1024 + col0 + bj * 32); bb[bj][1] = *(const f32x4*)(bg + 1024 + col0 + bj * 32 + 4); }
        u32x4 rb[2][4][2];
#pragma unroll
        for (int ai = 0; ai < 2; ++ai)
#pragma unroll
            for (int m = 0; m < 4; ++m) pb.fetch(ai, m, rb[ai][m][0], rb[ai][m][1]);
        asm volatile("" ::: "memory");
#pragma unroll
        for (int ai = 0; ai < 2; ++ai)
#pragma unroll
            for (int m = 0; m < 4; ++m) {
                pb.stage(rb[ai][m][0], rb[ai][m][1]); const u32x4 gb0 = pb.get(0), gb1 = pb.get(1);
                asm volatile("" ::: "memory");
#pragma unroll
                for (int bj = 0; bj < 2; ++bj) { const u32x4 gb = bj ? gb1 : gb0;
                    const f32x4 b0 = UNPK0(gb) + bb[bj][0], b1 = UNPK1(gb) + bb[bj][1];
                    f32x4 v0 = acc[ai][bj][m][0], v1 = acc[ai][bj][m][1];
#pragma unroll
                    for (int k = 0; k < 4; ++k) { v0[k] *= __builtin_amdgcn_rcpf(1.0f + eneg(b0[k])); v1[k] *= __builtin_amdgcn_rcpf(1.0f + eneg(b1[k])); }
                    po.put(bj, pack8(v0, v1)); }
                po.flush<false>(ai, m);
                asm volatile("" ::: "memory"); }
    }
};
struct EpiRes1 {
    static constexpr bool PERM = true, AFTER_DRAIN = false, HAS_MID = false, HAS_PRE = false;
    const float* x; bf16_t* X1; float* ss; PG8_LAS unsigned char* scr;
    __device__ __forceinline__ void operator()(const f32x4 (&acc)[2][2][4][2], const Unit& u, int wr, int wc, int fr, int fq) const {
        const int row0 = u.pm * BM + wr * 64 + fr, col0 = u.pn * BM + wc * 64 + 8 * fq;
        const PieceOut po(scr, X1, tm_block(u.pm, u.pn * 4 + wc, 16), wr, wc, fr, fq);
#pragma unroll
        for (int ai = 0; ai < 2; ++ai) {
            f32x4 xv[4][2][2];
#pragma unroll
            for (int m = 0; m < 4; ++m) { const float* xp = x + (size_t)(row0 + ai * HALF + m * 16) * 1024 + col0;
#pragma unroll
                for (int bj = 0; bj < 2; ++bj) { xv[m][bj][0] = *(const f32x4*)(xp + bj * 32); xv[m][bj][1] = *(const f32x4*)(xp + bj * 32 + 4); } }
            asm volatile("" ::: "memory");
#pragma unroll
            for (int m = 0; m < 4; ++m) { const int row = row0 + ai * HALF + m * 16; float sq = 0.f;
#pragma unroll
                for (int bj = 0; bj < 2; ++bj) { const f32x4 o0 = xv[m][bj][0] + acc[ai][bj][m][0], o1 = xv[m][bj][1] + acc[ai][bj][m][1];
                    sq += ((o0[0] * o0[0] + o0[1] * o0[1]) + (o0[2] * o0[2] + o0[3] * o0[3])) + ((o1[0] * o1[0] + o1[1] * o1[1]) + (o1[2] * o1[2] + o1[3] * o1[3]));
                    po.put(bj, pack8(o0, o1)); }
                po.flush<false>(ai, m);
                sq += __shfl_xor(sq, 16); sq += __shfl_xor(sq, 32);
                if (fq == 0) atomicAdd(ss + row, sq); }
        }
    }
};
struct EpiRes2 {
    static constexpr bool PERM = true, AFTER_DRAIN = false, HAS_MID = false, HAS_PRE = false;
    const bf16_t* X1; bf16_t* X2; float* ss; PG8_LAS unsigned char* scr;
    __device__ __forceinline__ void operator()(const f32x4 (&acc)[2][2][4][2], const Unit& u, int wr, int wc, int fr, int fq) const {
        const int row0 = u.pm * BM + wr * 64 + fr;
        const size_t blk = tm_block(u.pm, u.pn * 4 + wc, 16);
        const PieceIn pi(scr, X1, blk, wr, wc, fr, fq); const PieceOut po(scr, X2, blk, wr, wc, fr, fq);
        u32x4 rx[2][4][2];
#pragma unroll
        for (int ai = 0; ai < 2; ++ai)
#pragma unroll
            for (int m = 0; m < 4; ++m) pi.fetch(ai, m, rx[ai][m][0], rx[ai][m][1]);
        asm volatile("" ::: "memory");
#pragma unroll
        for (int ai = 0; ai < 2; ++ai)
#pragma unroll
            for (int m = 0; m < 4; ++m) { const int row = row0 + ai * HALF + m * 16; float sq = 0.f;
                pi.stage(rx[ai][m][0], rx[ai][m][1]); const u32x4 x0 = pi.get(0), x1 = pi.get(1);
                asm volatile("" ::: "memory");
#pragma unroll
                for (int bj = 0; bj < 2; ++bj) { const u32x4 z4 = bj ? x1 : x0;
                    const f32x4 o0 = UNPK0(z4) + acc[ai][bj][m][0], o1 = UNPK1(z4) + acc[ai][bj][m][1];
                    sq += ((o0[0] * o0[0] + o0[1] * o0[1]) + (o0[2] * o0[2] + o0[3] * o0[3])) + ((o1[0] * o1[0] + o1[1] * o1[1]) + (o1[2] * o1[2] + o1[3] * o1[3]));
                    po.put(bj, pack8(o0, o1)); }
                po.flush<false>(ai, m);
                asm volatile("" ::: "memory");
                sq += __shfl_xor(sq, 16); sq += __shfl_xor(sq, 32);
                if (fq == 0) atomicAdd(ss + row, sq); }
    }
};
struct EpiResNorm {
    static constexpr bool PERM = true, AFTER_DRAIN = false, HAS_MID = false, HAS_PRE = false;
    const bf16_t* X1; float* out; const float* gw; float* ss; unsigned* cnt; float eps; PG8_LAS unsigned char* scr;
    __device__ __forceinline__ void operator()(f32x4 (&acc)[2][2][4][2], const Unit& u, int wr, int wc, int fr, int fq) const {
        const int lane = fq * 16 + fr, row0 = u.pm * BM + wr * 64 + fr;
        const PieceIn pi(scr, X1, tm_block(u.pm, u.pn * 4 + wc, 16), wr, wc, fr, fq);
        u32x4 rx[2][4][2];
#pragma unroll
        for (int ai = 0; ai < 2; ++ai)
#pragma unroll
            for (int m = 0; m < 4; ++m) pi.fetch(ai, m, rx[ai][m][0], rx[ai][m][1]);
        asm volatile("" ::: "memory");
#pragma unroll
        for (int ai = 0; ai < 2; ++ai)
#pragma unroll
            for (int m = 0; m < 4; ++m) { const int row = row0 + ai * HALF + m * 16; float sq = 0.f;
                pi.stage(rx[ai][m][0], rx[ai][m][1]); const u32x4 x0 = pi.get(0), x1 = pi.get(1);
                asm volatile("" ::: "memory");
#pragma unroll
                for (int bj = 0; bj < 2; ++bj) { const u32x4 z4 = bj ? x1 : x0;
                    const f32x4 o0 = UNPK0(z4) + acc[ai][bj][m][0], o1 = UNPK1(z4) + acc[ai][bj][m][1];
                    acc[ai][bj][m][0] = o0; acc[ai][bj][m][1] = o1;
                    sq += ((o0[0] * o0[0] + o0[1] * o0[1]) + (o0[2] * o0[2] + o0[3] * o0[3])) + ((o1[0] * o1[0] + o1[1] * o1[1]) + (o1[2] * o1[2] + o1[3] * o1[3])); }
                sq += __shfl_xor(sq, 16); sq += __shfl_xor(sq, 32);
                if (fq == 0) atomicAdd(ss + row, sq); }
        asm volatile("s_waitcnt vmcnt(0)" ::: "memory");
        unsigned* c = cnt + 16 * u.pm;
        if (lane == 0) __hip_atomic_fetch_add(c, 1u, __ATOMIC_RELAXED, __HIP_MEMORY_SCOPE_AGENT);
        if (wr == 0 && wc == 0) { while (__hip_atomic_load(c, __ATOMIC_RELAXED, __HIP_MEMORY_SCOPE_AGENT) < 32u) __builtin_amdgcn_s_sleep(4); }
        asm volatile("s_waitcnt vmcnt(0) lgkmcnt(0)" ::: "memory"); __builtin_amdgcn_s_barrier(); asm volatile("" ::: "memory");
        float rs[2][4];
#pragma unroll
        for (int ai = 0; ai < 2; ++ai)
#pragma unroll
            for (int m = 0; m < 4; ++m) rs[ai][m] = __hip_atomic_load(ss + row0 + ai * HALF + m * 16, __ATOMIC_RELAXED, __HIP_MEMORY_SCOPE_AGENT);
        PG8_LAS unsigned char* my = scr + (wr * 4 + wc) * PG8_SCR_WAVE;
        PG8_LAS unsigned char* gp = my + fr * PG8_SCR_STRIDE + fq * 32;
        const PG8_LAS unsigned char* sp = my + (lane >> 3) * PG8_SCR_STRIDE + (lane & 7) * 16;
        float* ob = out + (size_t)(u.pm * BM + wr * 64 + (lane >> 3)) * 1024 + u.pn * BM + wc * 64 + (lane & 7) * 4;
        const int col0 = u.pn * BM + wc * 64 + 8 * fq;
#pragma unroll
        for (int bj = 0; bj < 2; ++bj) { const f32x4 g0 = *(const f32x4*)(gw + col0 + bj * 32), g1 = *(const f32x4*)(gw + col0 + bj * 32 + 4);
#pragma unroll
            for (int ai = 0; ai < 2; ++ai)
#pragma unroll
                for (int m = 0; m < 4; ++m) { const float r = __builtin_amdgcn_rsqf(rs[ai][m] * (1.0f / 1024.0f) + eps);
                    *(PG8_LAS f32x4*)gp = acc[ai][bj][m][0] * r * g0; *(PG8_LAS f32x4*)(gp + 16) = acc[ai][bj][m][1] * r * g1;
                    const f32x4 v0 = *(const PG8_LAS f32x4*)sp, v1 = *(const PG8_LAS f32x4*)(sp + 8 * PG8_SCR_STRIDE);
                    float* op = ob + (size_t)(ai * HALF + m * 16) * 1024 + bj * 32;
                    __builtin_nontemporal_store(v0, (f32x4*)op); __builtin_nontemporal_store(v1, (f32x4*)(op + 8 * 1024));
                    asm volatile("" ::: "memory"); } }
    }
};
struct EpiUp {
    static constexpr bool PERM = true, AFTER_DRAIN = false, HAS_MID = false, HAS_PRE = true;
    bf16_t* O; const float* ss; float eps; PG8_LAS unsigned char* scr;
    __device__ __forceinline__ void pre(float (&st)[8], const Unit& u, int wr, int wc, int fr, int fq) const {
        const float* sp = ss + u.pm * BM + wr * 64 + fr;
#pragma unroll
        for (int i = 0; i < 8; ++i) st[i] = sp[(i >> 2) * HALF + (i & 3) * 16];
    }
    __device__ __forceinline__ void post(const f32x4 (&acc)[2][2][4][2], const float (&st)[8], const Unit& u, int wr, int wc, int fr, int fq) const {
        const PieceOut po(scr, O, tm_block(u.pm, u.pn * 4 + wc, 64), wr, wc, fr, fq);
#pragma unroll
        for (int ai = 0; ai < 2; ++ai)
#pragma unroll
            for (int m = 0; m < 4; ++m) { const float rs = __builtin_amdgcn_rsqf(st[ai * 4 + m] * (1.0f / 1024.0f) + eps);
#pragma unroll
                for (int bj = 0; bj < 2; ++bj) { f32x4 v0 = acc[ai][bj][m][0] * rs, v1 = acc[ai][bj][m][1] * rs;
#pragma unroll
                    for (int k = 0; k < 4; ++k) { const float a = fmaxf(v0[k], 0.f), b = fmaxf(v1[k], 0.f); v0[k] = a * a; v1[k] = b * b; }
                    po.put(bj, pack8(v0, v1)); }
                po.flush<true>(ai, m); }
    }
};
template <class Epi, class Sched, bool ALIGN_EPI = false, bool SP2 = false>
__device__ __forceinline__ void gemm_phase(PG8_LAS unsigned char* lds, const Gemm g, const Sched& S, const Epi& E) {
    const int tid = threadIdx.x, wid = __builtin_amdgcn_readfirstlane(tid >> 6), lane = tid & 63, wr = wid >> 2, wc = wid & 3, fr = lane & 15, fq = lane >> 4;
    const int K = g.K, nt = K / BK;
    unsigned voffA[2], voffB[2];
#pragma unroll
    for (int i = 0; i < 2; ++i) { int R, C; stage_rc(tid * 16 + i * 8192, R, C); const int Rb = Epi::PERM ? (64 * (R >> 5) + perm32(R & 31)) : R;
        voffA[i] = (unsigned)(R * 64 + C) * 2u; voffB[i] = (unsigned)(Rb * 64 + C) * 2u; }
    const size_t kstep = (size_t)32768;
    const size_t hstep = (size_t)HALF * 128;
    const size_t tstep = (size_t)256 * K * 2; const size_t hstepB = Epi::PERM ? (size_t)32 * 128 : hstep;
    const unsigned ldsw = (unsigned)wid * 1024u;
    const int aoff = lds_byte(wr * 64 + fr, fq * 8), boff = lds_byte(wc * 32 + fr, fq * 8);
#define PG8_SA(b, h) (((b) * 2 + (h)) * HTB)
#define PG8_SB(b, h) ((4 + (b) * 2 + (h)) * HTB)
#define PG8_STAGE(bufoff, gbase, voff) do { _Pragma("unroll") for (int _i = 0; _i < 2; ++_i) \
        __builtin_amdgcn_global_load_lds((const unsigned*)((const char*)(gbase) + (voff)[_i]), (PG8_LAS unsigned*)(lds + (bufoff) + ldsw + _i * 8192), 16, 0, 0); } while (0)
#define PG8_LDA(dst, b, h) do { _Pragma("unroll") for (int m = 0; m < 4; ++m) _Pragma("unroll") for (int k = 0; k < 2; ++k) dst[m][k] = *(const PG8_LAS bf16x8*)(lds + PG8_SA(b, h) + aoff + m * 2048 + k * 1024); } while (0)
#define PG8_LDB(dst, b, h) do { _Pragma("unroll") for (int n = 0; n < 2; ++n) _Pragma("unroll") for (int k = 0; k < 2; ++k) dst[n][k] = *(const PG8_LAS bf16x8*)(lds + PG8_SB(b, h) + boff + n * 2048 + k * 1024); } while (0)
#define PG8_MMA(ai, bj, At, Bt) do { __builtin_amdgcn_s_setprio(1); _Pragma("unroll") for (int m = 0; m < 4; ++m) _Pragma("unroll") for (int n = 0; n < 2; ++n) _Pragma("unroll") for (int k = 0; k < 2; ++k) \
        acc[ai][bj][m][n] = __builtin_amdgcn_mfma_f32_16x16x32_bf16(Bt[n][k], At[m][k], acc[ai][bj][m][n], 0, 0, 0); __builtin_amdgcn_s_setprio(0); } while (0)
#define PG8_WAIT_V(n) asm volatile("s_waitcnt vmcnt(" #n ")" ::: "memory")
#define PG8_WAIT_L(n) asm volatile("s_waitcnt lgkmcnt(" #n ")" ::: "memory")
#define PG8_BAR __builtin_amdgcn_s_barrier()
#define PG8_SCHED __builtin_amdgcn_sched_barrier(0)
    Unit cur, nxt; int ui = 0;
    if (!S.next(0, cur)) return;
    f32x4 acc[2][2][4][2];
#pragma unroll
    for (int a = 0; a < 2; ++a)
#pragma unroll
        for (int b = 0; b < 2; ++b)
#pragma unroll
            for (int m = 0; m < 4; ++m)
#pragma unroll
                for (int n = 0; n < 2; ++n) acc[a][b][m][n] = (f32x4){0.f, 0.f, 0.f, 0.f};
    bf16x8 At[4][2], B0[2][2], B1[2][2];
    const char* cA = (const char*)g.A + (size_t)cur.pm * tstep; const char* cB = (const char*)g.Bt + (size_t)cur.pn * tstep;
    S.a_ready(cur);
    float pre_st[8];
    if constexpr (Epi::HAS_PRE) E.pre(pre_st, cur, wr, wc, fr, fq);
    if constexpr (SP2) {
        PG8_STAGE(PG8_SB(0, 0), cB, voffB); PG8_STAGE(PG8_SB(0, 1), cB + hstepB, voffB); PG8_STAGE(PG8_SA(0, 0), cA, voffA); PG8_STAGE(PG8_SA(0, 1), cA + hstep, voffA);
        if (wr == 1) PG8_BAR;
        PG8_WAIT_V(2); PG8_BAR;
        PG8_STAGE(PG8_SB(1, 0), cB + kstep, voffB); PG8_STAGE(PG8_SA(1, 0), cA + kstep, voffA); PG8_STAGE(PG8_SB(1, 1), cB + hstepB + kstep, voffB);
        PG8_WAIT_V(6); PG8_BAR;
    } else {
        PG8_STAGE(PG8_SB(0, 0), cB, voffB); PG8_STAGE(PG8_SA(0, 0), cA, voffA); PG8_STAGE(PG8_SB(0, 1), cB + hstepB, voffB); PG8_STAGE(PG8_SA(0, 1), cA + hstep, voffA);
        if (wr == 1) PG8_BAR;
        PG8_WAIT_V(4); PG8_BAR;
        PG8_STAGE(PG8_SB(1, 0), cB + kstep, voffB); PG8_STAGE(PG8_SA(1, 0), cA + kstep, voffA); PG8_STAGE(PG8_SB(1, 1), cB + hstepB + kstep, voffB);
        PG8_WAIT_V(6); PG8_BAR;
    }
    for (;;) {
        const bool has_next = S.next(ui + 1, nxt);
        const char* nA = has_next ? (const char*)g.A + (size_t)nxt.pm * tstep : cA; const char* nB = has_next ? (const char*)g.Bt + (size_t)nxt.pn * tstep : cB;
        for (int t = 0; t < nt; t += 2) {
            if constexpr (Epi::HAS_MID) { if (t == (nt >> 1)) E.mid(acc, cur, wr, wc, fr, fq); }
            const bool last = (t == nt - 2);
            const char* a1 = cA + (size_t)(t + 1) * kstep;
            const char* a2 = last ? nA : cA + (size_t)(t + 2) * kstep; const char* b2 = last ? nB : cB + (size_t)(t + 2) * kstep;
            const char* a3 = a2 + kstep; const char* b3 = b2 + kstep;
            if (last && has_next) S.a_ready(nxt);
            if constexpr (SP2) {
            PG8_LDB(B0, 0, 0); PG8_LDB(B1, 0, 1); PG8_SCHED; PG8_LDA(At, 0, 0); PG8_STAGE(PG8_SA(1, 1), a1 + hstep, voffA);
            PG8_WAIT_V(8); PG8_WAIT_L(0); PG8_BAR; PG8_MMA(0, 0, At, B0); PG8_MMA(0, 1, At, B1); PG8_BAR; PG8_SCHED;
            PG8_LDA(At, 0, 1); PG8_STAGE(PG8_SB(0, 0), b2, voffB); PG8_STAGE(PG8_SB(0, 1), b2 + hstepB, voffB); PG8_STAGE(PG8_SA(0, 0), a2, voffA);
            PG8_WAIT_V(8); PG8_WAIT_L(0); PG8_BAR; PG8_MMA(1, 0, At, B0); PG8_MMA(1, 1, At, B1); PG8_BAR; PG8_SCHED;
            PG8_LDB(B0, 1, 0); PG8_LDB(B1, 1, 1); PG8_SCHED; PG8_LDA(At, 1, 0); PG8_STAGE(PG8_SA(0, 1), a2 + hstep, voffA);
            PG8_WAIT_V(8); PG8_WAIT_L(0); PG8_BAR; PG8_MMA(0, 0, At, B0); PG8_MMA(0, 1, At, B1); PG8_BAR; PG8_SCHED;
            PG8_LDA(At, 1, 1); PG8_STAGE(PG8_SB(1, 0), b3, voffB); PG8_STAGE(PG8_SB(1, 1), b3 + hstepB, voffB); PG8_STAGE(PG8_SA(1, 0), a3, voffA);
            PG8_WAIT_V(8); PG8_WAIT_L(0); PG8_BAR; PG8_MMA(1, 0, At, B0); PG8_MMA(1, 1, At, B1); PG8_BAR; PG8_SCHED;
            } else {
            PG8_LDB(B0, 0, 0); PG8_SCHED; PG8_LDA(At, 0, 0); PG8_STAGE(PG8_SA(1, 1), a1 + hstep, voffA);
            PG8_WAIT_L(8); PG8_BAR; PG8_WAIT_L(0); PG8_MMA(0, 0, At, B0); PG8_BAR; PG8_SCHED;
            PG8_LDB(B1, 0, 1); PG8_STAGE(PG8_SB(0, 0), b2, voffB);
            PG8_BAR; PG8_WAIT_L(0); PG8_MMA(0, 1, At, B1); PG8_BAR;
            PG8_LDA(At, 0, 1); PG8_STAGE(PG8_SA(0, 0), a2, voffA);
            PG8_BAR; PG8_WAIT_L(0); PG8_MMA(1, 0, At, B0); PG8_BAR; PG8_SCHED;
            PG8_STAGE(PG8_SB(0, 1), b2 + hstepB, voffB);
            PG8_WAIT_V(6); PG8_BAR; PG8_MMA(1, 1, At, B1); PG8_BAR;
            PG8_LDB(B0, 1, 0); PG8_SCHED; PG8_LDA(At, 1, 0); PG8_STAGE(PG8_SA(0, 1), a2 + hstep, voffA);
            PG8_WAIT_L(8); PG8_BAR; PG8_WAIT_L(0); PG8_MMA(0, 0, At, B0); PG8_BAR; PG8_SCHED;
            PG8_LDB(B1, 1, 1); PG8_STAGE(PG8_SB(1, 0), b3, voffB);
            PG8_BAR; PG8_WAIT_L(0); PG8_MMA(0, 1, At, B1); PG8_BAR;
            PG8_LDA(At, 1, 1); PG8_STAGE(PG8_SA(1, 0), a3, voffA);
            PG8_BAR; PG8_WAIT_L(0); PG8_MMA(1, 0, At, B0); PG8_BAR; PG8_SCHED;
            PG8_STAGE(PG8_SB(1, 1), b3 + hstepB, voffB);
            PG8_WAIT_V(6); PG8_BAR; PG8_MMA(1, 1, At, B1); PG8_BAR;
            }
        }
        if constexpr (ALIGN_EPI) { if (wr == 0) PG8_BAR; }
        if constexpr (!Epi::AFTER_DRAIN) { if constexpr (Epi::HAS_PRE) { E.post(acc, pre_st, cur, wr, wc, fr, fq); if (has_next) E.pre(pre_st, nxt, wr, wc, fr, fq); } else E(acc, cur, wr, wc, fr, fq); S.done(cur); }
        if (!has_next) break;
#pragma unroll
        for (int a = 0; a < 2; ++a)
#pragma unroll
            for (int b = 0; b < 2; ++b)
#pragma unroll
                for (int m = 0; m < 4; ++m)
#pragma unroll
                    for (int n = 0; n < 2; ++n) acc[a][b][m][n] = (f32x4){0.f, 0.f, 0.f, 0.f};
        cur = nxt; cA = nA; cB = nB; ++ui;
        if constexpr (ALIGN_EPI) { if (wr == 1) PG8_BAR; }
    }
    PG8_WAIT_V(0);
    if constexpr (!ALIGN_EPI) { if (wr == 0) PG8_BAR; }
    PG8_BAR;
    if constexpr (Epi::AFTER_DRAIN) { E.fused(acc, cur, wr, wc, fr, fq, lds, wid, lane); S.done(cur); }
#undef PG8_SA
#undef PG8_SB
#undef PG8_STAGE
#undef PG8_LDA
#undef PG8_LDB
#undef PG8_MMA
#undef PG8_WAIT_V
#undef PG8_WAIT_L
#undef PG8_BAR
#undef PG8_SCHED
}
}
#ifndef PG8_SP2
#define PG8_SP2 true
#endif
#ifndef PG8_ALIGN
#define PG8_ALIGN true
#endif
#ifndef MK_MULTI
#define MK_MULTI 0
#endif

constexpr int BATCH = 8, SEQ = 8192, DM = 1024, FF = 4096, M = BATCH * SEQ;
constexpr int ZLD = 4352;
constexpr int Z_QA = 0, Z_KA = 512, Z_VA = 640, Z_QB = 768, Z_KB = 1280, Z_VB = 1792, Z_GA = 2304, Z_GB = 3328;
constexpr float EPS = 1e-6f, LOG2E = 1.4426950408889634f;
constexpr int NWAVES = 8, NTHREADS = 512;
constexpr size_t MiB = 1u << 20;
constexpr size_t WS_SS1 = 0, WS_SS2 = 256 * 1024, WS_CNT = 512 * 1024, WS_BAR = 768 * 1024, WS_BAR_BYTES = 16384;
constexpr size_t WS_WIN = 1 * MiB;
constexpr size_t WS_WPA = 10 * MiB, WS_WPB = 11 * MiB;
constexpr size_t WS_WOUT = 12 * MiB;
constexpr size_t WS_WUP = 14 * MiB;
constexpr size_t WS_WDN = 22 * MiB;
constexpr size_t WS_XN = 32 * MiB;
constexpr size_t WS_YA = 160 * MiB, WS_YB = 224 * MiB;
constexpr size_t WS_X2 = 160 * MiB;
constexpr size_t WS_MG = 288 * MiB;
constexpr size_t WS_Z = 416 * MiB;
constexpr size_t WS_END = 960 * MiB;
constexpr int LDS_BYTES = 155648;
#define LAS __attribute__((address_space(3)))
typedef unsigned short bf16;
typedef unsigned v4u __attribute__((ext_vector_type(4)));
typedef unsigned v2u __attribute__((ext_vector_type(2)));
typedef float f32x4 __attribute__((ext_vector_type(4)));
typedef short bf16x8 __attribute__((ext_vector_type(8)));
typedef short s16x4 __attribute__((ext_vector_type(4)));
#define LDS_WAIT() asm volatile("s_waitcnt lgkmcnt(0)" ::: "memory")
__device__ __forceinline__ unsigned f2bf(float f) { unsigned u = __builtin_bit_cast(unsigned, f); return (u + 0x7fffu + ((u >> 16) & 1u)) >> 16; }
__device__ __forceinline__ unsigned pk2(float lo, float hi) { return pg8::cvt_pk_bf16(lo, hi); }
__device__ __forceinline__ float wave_sum(float v) {
#pragma unroll
    for (int o = 1; o < 64; o <<= 1) v += __shfl_xor(v, o);
    return v;
}
__device__ __forceinline__ size_t tmo(int row, int ct, int nct) { return ((size_t)(row >> 8) * nct + ct) * 32768 + (size_t)(row & 255) * 128; }
__device__ __forceinline__ void p0_transpose_item(const float* W, int K, int N, bf16* WT, LAS float* scr, int item, int lane, const float* gk = nullptr, int ldw = 0, int koff = 0) {
    if (ldw == 0) ldw = K;
    const int nblk = N / 32, kb = item / nblk, nb = item % nblk, k0 = 64 * kb, n0 = 32 * nb;
    float wv[32];
    const float* wp = W + (size_t)(k0 + (lane >> 5)) * N + n0 + (lane & 31);
#pragma unroll
    for (int i = 0; i < 32; ++i) wv[i] = __builtin_nontemporal_load(wp + (size_t)(2 * i) * N);
#pragma unroll
    for (int i = 0; i < 32; ++i) { const int kk = 2 * i + (lane >> 5); scr[kk * 33 + (lane & 31)] = wv[i] * (gk ? gk[k0 + kk] : 1.0f); }
    LDS_WAIT(); asm volatile("" ::: "memory");
    const int c = lane & 7;
#pragma unroll
    for (int j = 0; j < 4; ++j) { const int n = (lane >> 3) + 8 * j; const LAS float* s = scr + (8 * c) * 33 + n;
        v4u o; o.x = pk2(s[0 * 33], s[1 * 33]); o.y = pk2(s[2 * 33], s[3 * 33]); o.z = pk2(s[4 * 33], s[5 * 33]); o.w = pk2(s[6 * 33], s[7 * 33]);
        *(v4u*)((unsigned char*)WT + tmo(n0 + n, (koff + k0) >> 6, ldw >> 6) + 16 * c) = o; }
    LDS_WAIT(); asm volatile("" ::: "memory");
}
__device__ __forceinline__ void rms_row_to_bf16(const float* xrow, const float* g, bf16* orow, int lane) {
    const f32x4* xr = (const f32x4*)xrow + lane; const f32x4* gr = (const f32x4*)g + lane;
    f32x4 v[4]; float s = 0.f;
#pragma unroll
    for (int j = 0; j < 4; ++j) { v[j] = xr[64 * j]; s += (v[j].x * v[j].x + v[j].y * v[j].y) + (v[j].z * v[j].z + v[j].w * v[j].w); }
    const float rstd = 1.0f / sqrtf(wave_sum(s) * (1.f / DM) + EPS);
    unsigned long long* o8 = (unsigned long long*)orow + lane;
#pragma unroll
    for (int j = 0; j < 4; ++j) { const f32x4 gg = gr[64 * j]; const f32x4 t = v[j] * rstd * gg;
        o8[64 * j] = (unsigned long long)pk2(t.x, t.y) | ((unsigned long long)pk2(t.z, t.w) << 32); }
}
__device__ __forceinline__ int swz(int row, int chunk) { return row * 128 + ((chunk ^ (row & 7)) << 4); }
__device__ __forceinline__ s16x4 vtr(const LAS unsigned char* p) { return __builtin_bit_cast(s16x4, __builtin_amdgcn_ds_read_tr16_b64_v4i16((LAS s16x4*)p)); }
#define MFMA16(a, b, c) __builtin_amdgcn_mfma_f32_16x16x32_bf16((a), (b), (c), 0, 0, 0)

__device__ __forceinline__ void qk_step(const LAS unsigned char* Kl, int rb0, int rb1, int lq, int g, bf16x8 qf0, bf16x8 qf1, f32x4& S0, f32x4& S1) {
    const bf16x8 k00 = *(const LAS bf16x8*)(Kl + swz(rb0 + lq, g)), k01 = *(const LAS bf16x8*)(Kl + swz(rb0 + lq, 4 + g));
    const bf16x8 k10 = *(const LAS bf16x8*)(Kl + swz(rb1 + lq, g)), k11 = *(const LAS bf16x8*)(Kl + swz(rb1 + lq, 4 + g));
    const f32x4 z = {0.f, 0.f, 0.f, 0.f};
    S0 = MFMA16(k00, qf0, z); S0 = MFMA16(k01, qf1, S0);
    S1 = MFMA16(k10, qf0, z); S1 = MFMA16(k11, qf1, S1);
}
__device__ __forceinline__ void pv_step(const LAS unsigned char* Vl, int rb0, int rb1, int lane, int g, const f32x4& P0, const f32x4& P1, f32x4 (&O)[4]) {
    v4u pw; pw.x = pk2(P0[0], P0[1]); pw.y = pk2(P0[2], P0[3]); pw.z = pk2(P1[0], P1[1]); pw.w = pk2(P1[2], P1[3]);
    const bf16x8 pb = __builtin_bit_cast(bf16x8, pw);
    const int i = lane & 15, rq = i >> 2, p = i & 3;
    const int r0 = rb0 + 4 * g + rq, r1 = rb1 + 4 * g + rq;
#pragma unroll
    for (int db = 0; db < 4; ++db) {
        const s16x4 lo = vtr(Vl + swz(r0, 2 * db + (p >> 1)) + 8 * (p & 1));
        const s16x4 hi = vtr(Vl + swz(r1, 2 * db + (p >> 1)) + 8 * (p & 1));
        const bf16x8 vt = (bf16x8){lo[0], lo[1], lo[2], lo[3], hi[0], hi[1], hi[2], hi[3]};
        O[db] = MFMA16(vt, pb, O[db]);
    }
}
__device__ __forceinline__ void qk_at(const LAS unsigned char* kp0, const LAS unsigned char* kp1, int off, bf16x8 qf0, bf16x8 qf1, f32x4& S0, f32x4& S1) {
    const bf16x8 k00 = *(const LAS bf16x8*)(kp0 + off), k01 = *(const LAS bf16x8*)(kp1 + off);
    const bf16x8 k10 = *(const LAS bf16x8*)(kp0 + off + 2048), k11 = *(const LAS bf16x8*)(kp1 + off + 2048);
    const f32x4 z = {0.f, 0.f, 0.f, 0.f};
    S0 = MFMA16(k00, qf0, z); S0 = MFMA16(k01, qf1, S0);
    S1 = MFMA16(k10, qf0, z); S1 = MFMA16(k11, qf1, S1);
}
__device__ __forceinline__ void pv_at(const LAS unsigned char* const (&vp)[4], int off, const f32x4& P0, const f32x4& P1, f32x4 (&O)[4]) {
    v4u pw; pw.x = pk2(P0[0], P0[1]); pw.y = pk2(P0[2], P0[3]); pw.z = pk2(P1[0], P1[1]); pw.w = pk2(P1[2], P1[3]);
    const bf16x8 pb = __builtin_bit_cast(bf16x8, pw);
#pragma unroll
    for (int db = 0; db < 4; ++db) {
        const s16x4 lo = vtr(vp[db] + off), hi = vtr(vp[db] + off + 2048);
        const bf16x8 vt = (bf16x8){lo[0], lo[1], lo[2], lo[3], hi[0], hi[1], hi[2], hi[3]};
        O[db] = MFMA16(vt, pb, O[db]);
    }
}
__device__ __forceinline__ float xrow16_max(float x) {
    auto s = __builtin_amdgcn_permlane16_swap(__float_as_uint(x), __float_as_uint(x), false, false);
    x = fmaxf(__uint_as_float(s[0]), __uint_as_float(s[1]));
    auto t = __builtin_amdgcn_permlane32_swap(__float_as_uint(x), __float_as_uint(x), false, false);
    return fmaxf(__uint_as_float(t[0]), __uint_as_float(t[1]));
}
__device__ __forceinline__ float xrow16_sum(float x) {
    auto s = __builtin_amdgcn_permlane16_swap(__float_as_uint(x), __float_as_uint(x), false, false);
    x = __uint_as_float(s[0]) + __uint_as_float(s[1]);
    auto t = __builtin_amdgcn_permlane32_swap(__float_as_uint(x), __float_as_uint(x), false, false);
    return __uint_as_float(t[0]) + __uint_as_float(t[1]);
}
__device__ __forceinline__ void softmax_step(f32x4& s0, f32x4& s1, float& m, float& l, f32x4 (&O)[4]) {
    float t = fmaxf(fmaxf(fmaxf(s0[0], s0[1]), fmaxf(s0[2], s0[3])), fmaxf(fmaxf(s1[0], s1[1]), fmaxf(s1[2], s1[3])));
    t = xrow16_max(t);
    const float mn = fmaxf(m, t), alpha = __builtin_amdgcn_exp2f(m - mn);
    m = mn;
#pragma unroll
    for (int k = 0; k < 4; ++k) { s0[k] = __builtin_amdgcn_exp2f(s0[k] - mn); s1[k] = __builtin_amdgcn_exp2f(s1[k] - mn); }
    l = l * alpha + ((s0[0] + s0[1]) + (s0[2] + s0[3])) + ((s1[0] + s1[1]) + (s1[2] + s1[3]));
#pragma unroll
    for (int db = 0; db < 4; ++db) O[db] *= alpha;
}
__device__ __forceinline__ void store_o(bf16* yrow, int g, float l, const f32x4 (&O)[4]) {
    const float inv = 1.0f / xrow16_sum(l);
    unsigned wx[4], wy[4];
#pragma unroll
    for (int db = 0; db < 4; ++db) { wx[db] = pk2(O[db][0] * inv, O[db][1] * inv); wy[db] = pk2(O[db][2] * inv, O[db][3] * inv); }
#pragma unroll
    for (int p = 0; p < 2; ++p) {
        auto rx = __builtin_amdgcn_permlane16_swap(wx[2 * p], wx[2 * p + 1], false, false); wx[2 * p] = rx[0]; wx[2 * p + 1] = rx[1];
        auto ry = __builtin_amdgcn_permlane16_swap(wy[2 * p], wy[2 * p + 1], false, false); wy[2 * p] = ry[0]; wy[2 * p + 1] = ry[1]; }
#pragma unroll
    for (int p = 0; p < 2; ++p) {
        auto rx = __builtin_amdgcn_permlane32_swap(wx[p], wx[p + 2], false, false); wx[p] = rx[0]; wx[p + 2] = rx[1];
        auto ry = __builtin_amdgcn_permlane32_swap(wy[p], wy[p + 2], false, false); wy[p] = ry[0]; wy[p + 2] = ry[1]; }
    v4u lo = {wx[0], wy[0], wx[1], wy[1]}, hi = {wx[2], wy[2], wx[3], wy[3]};
    *(v4u*)(yrow + 16 * g) = lo; *(v4u*)(yrow + 16 * g + 8) = hi;
}

constexpr int A_ROWS = 400, A_KOFF = 0, A_VOFF = A_ROWS * 128;
template <bool MASK> __device__ __forceinline__ void a_scores(f32x4& S0, f32x4& S1, float basef, float c1, float slope2, int krow0, int kstart) {
#pragma unroll
    for (int r = 0; r < 4; ++r) {
        const float d0 = fabsf(basef - (float)r), d1 = fabsf(basef - (float)(16 + r));
        const float v0 = S0[r] - slope2 * d0, v1 = S1[r] - slope2 * d1;
        if (MASK) { const int p0 = kstart + krow0 + r, p1 = p0 + 16;
            S0[r] = (d0 <= 128.f && p0 >= 0 && p0 < SEQ) ? v0 : -INFINITY; S1[r] = (d1 <= 128.f && p1 >= 0 && p1 < SEQ) ? v1 : -INFINITY; }
        else { S0[r] = v0; S1[r] = v1; }
    }
}
__device__ __forceinline__ void attn_a_prefetch(const bf16* Z, int unit, v4u (&kr)[7], v4u (&vr)[7]) {
    const int tid = threadIdx.x; const int ib = unit & 63, kvh = (unit >> 6) & 1, b = unit >> 7;
    const size_t tok0 = (size_t)b * SEQ; const int kstart = (ib - 1) * 128;
#pragma unroll
    for (int k = 0; k < 7; ++k) { const int it = tid + k * NTHREADS; const int row = it >> 3, ch = it & 7, pos = kstart + row;
        kr[k] = (v4u){0u, 0u, 0u, 0u}; vr[k] = (v4u){0u, 0u, 0u, 0u};
        if (it < A_ROWS * 8 && row < 384 && pos >= 0 && pos < SEQ) { const int t = (int)tok0 + pos; kr[k] = *(const v4u*)((const unsigned char*)Z + tmo(t, Z_KA / 64 + kvh, ZLD / 64) + ch * 16); vr[k] = *(const v4u*)((const unsigned char*)Z + tmo(t, Z_VA / 64 + kvh, ZLD / 64) + ch * 16); } }
}
__device__ __forceinline__ void attn_a_commit(LAS unsigned char* lds, const v4u (&kr)[7], const v4u (&vr)[7]) {
    const int tid = threadIdx.x; LAS unsigned char* Kl = lds + A_KOFF; LAS unsigned char* Vl = lds + A_VOFF;
#pragma unroll
    for (int k = 0; k < 7; ++k) { const int it = tid + k * NTHREADS; const int row = it >> 3, ch = it & 7;
        if (it < A_ROWS * 8) { *(LAS v4u*)(Kl + swz(row, ch)) = kr[k]; *(LAS v4u*)(Vl + swz(row, ch)) = vr[k]; } }
}
__device__ __forceinline__ void attn_a_unit(LAS unsigned char* lds, const bf16* Z, bf16* Y, const float* sink, int unit) {
    const int tid = threadIdx.x, lane = tid & 63, wid = tid >> 6, lq = lane & 15, g = lane >> 4;
    const int ib = unit & 63, kvh = (unit >> 6) & 1, b = unit >> 7;
    const size_t tok0 = (size_t)b * SEQ; const int kstart = (ib - 1) * 128;
    LAS unsigned char* Kl = lds + A_KOFF; LAS unsigned char* Vl = lds + A_VOFF;
    const int hq = kvh * 4 + (wid >> 1);
    const float slope2 = __builtin_amdgcn_exp2f(-(float)(hq + 1)) * LOG2E, sink2 = sink[hq] * LOG2E, c1 = 0.125f * LOG2E;
    const bool edge = (ib == 0) || (ib == 63);
    for (int bp = 0; bp < 2; ++bp) {
        const int qoffA = (wid & 1) * 64 + bp * 32, qoffB = qoffA + 16;
        const size_t qtokA = tok0 + ib * 128 + qoffA + lq, qtokB = qtokA + 16;
        const unsigned char* qpA = (const unsigned char*)Z + tmo((int)qtokA, Z_QA / 64 + hq, ZLD / 64) + 16 * g; const unsigned char* qpB = qpA + 16 * 128;
        const bf16x8 qA0 = *(const bf16x8*)qpA, qA1 = *(const bf16x8*)(qpA + 64), qB0 = *(const bf16x8*)qpB, qB1 = *(const bf16x8*)(qpB + 64);
        float mA = sink2, lA = (g == 0) ? 1.0f : 0.0f, mB = sink2, lB = lA;
        f32x4 OA[4], OB[4];
#pragma unroll
        for (int d = 0; d < 4; ++d) { OA[d] = (f32x4){0.f, 0.f, 0.f, 0.f}; OB[d] = (f32x4){0.f, 0.f, 0.f, 0.f}; }
        if (edge) {
        for (int st = 0; st < 9; ++st) {
            const int rbA = qoffA + 32 * st, rbB = rbA + 16;
            f32x4 SA0, SA1, SB0, SB1;
            qk_step(Kl, rbA, rbA + 16, lq, g, qA0, qA1, SA0, SA1);
            qk_step(Kl, rbB, rbB + 16, lq, g, qB0, qB1, SB0, SB1);
            const float basef = (float)(128 + lq - 32 * st - 4 * g);
            a_scores<true>(SA0, SA1, basef, c1, slope2, rbA + 4 * g, kstart); a_scores<true>(SB0, SB1, basef, c1, slope2, rbB + 4 * g, kstart);
            softmax_step(SA0, SA1, mA, lA, OA);
            softmax_step(SB0, SB1, mB, lB, OB);
            pv_step(Vl, rbA, rbA + 16, lane, g, SA0, SA1, OA);
            pv_step(Vl, rbB, rbB + 16, lane, g, SB0, SB1, OB);
        }
        } else {
        const LAS unsigned char* kp0 = Kl + swz(qoffA + lq, g); const LAS unsigned char* kp1 = Kl + swz(qoffA + lq, 4 + g);
        const LAS unsigned char* vp[4];
        { const int i = lane & 15, rq4 = i >> 2, p = i & 3;
#pragma unroll
          for (int db = 0; db < 4; ++db) vp[db] = Vl + swz(qoffA + 4 * g + rq4, 2 * db + (p >> 1)) + 8 * (p & 1); }
        float basef = (float)(128 + lq - 4 * g);
#define A_STEP(MASKED, ST) do { f32x4 SA0, SA1, SB0, SB1; \
            qk_at(kp0, kp1, 0, qA0, qA1, SA0, SA1); qk_at(kp0, kp1, 2048, qB0, qB1, SB0, SB1); \
            if (MASKED) { const int rbA_ = qoffA + 32 * (ST); a_scores<true>(SA0, SA1, basef, c1, slope2, rbA_ + 4 * g, kstart); a_scores<true>(SB0, SB1, basef, c1, slope2, rbA_ + 16 + 4 * g, kstart); } \
            else { a_scores<false>(SA0, SA1, basef, c1, slope2, 0, 0); a_scores<false>(SB0, SB1, basef, c1, slope2, 0, 0); } \
            softmax_step(SA0, SA1, mA, lA, OA); softmax_step(SB0, SB1, mB, lB, OB); \
            pv_at(vp, 0, SA0, SA1, OA); pv_at(vp, 2048, SB0, SB1, OB); \
            kp0 += 4096; kp1 += 4096; basef -= 32.f; _Pragma("unroll") for (int db_ = 0; db_ < 4; ++db_) vp[db_] += 4096; } while (0)
        A_STEP(true, 0);
        for (int st = 1; st < 8; ++st) A_STEP(false, st);
        A_STEP(true, 8);
#undef A_STEP
        }
        store_o((bf16*)((unsigned char*)Y + tmo((int)qtokA, hq, 16)), g, lA, OA);
        store_o((bf16*)((unsigned char*)Y + tmo((int)qtokB, hq, 16)), g, lB, OB);
    }
}
constexpr int B_ROWS = 9 * 64, B_KOFF = 0, B_VOFF = B_ROWS * 128, B_TOFF = 2 * B_ROWS * 128, B_TREAL = 544, B_TSIZE = 800;
static_assert(B_TOFF + B_TSIZE * 4 <= LDS_BYTES && A_VOFF + A_ROWS * 128 <= LDS_BYTES, "LDS map");
__device__ __forceinline__ int clampi(int v, int lo, int hi) { return v < lo ? lo : (v > hi ? hi : v); }
__device__ __forceinline__ void attn_b_prefetch(const bf16* Z, const float* rpb, int unit, v4u (&kr)[9], v4u (&vr)[9], float (&tr)[2]) {
    const int tid = threadIdx.x; const int rp = unit & 63, h = (unit >> 6) & 7, b = unit >> 9;
    const size_t tok0 = (size_t)b * SEQ; const int R0 = clampi(2 * rp - 4, 0, 120);
#pragma unroll
    for (int k = 0; k < 9; ++k) { const int it = tid + k * NTHREADS; const int row = it >> 3, ch = it & 7, gr = R0 + (row >> 6);
        kr[k] = (v4u){0u, 0u, 0u, 0u}; vr[k] = (v4u){0u, 0u, 0u, 0u};
        if (gr < 128) { const int t = (int)tok0 + gr * 64 + (row & 63); kr[k] = *(const v4u*)((const unsigned char*)Z + tmo(t, Z_KB / 64 + h, ZLD / 64) + ch * 16); vr[k] = *(const v4u*)((const unsigned char*)Z + tmo(t, Z_VB / 64 + h, ZLD / 64) + ch * 16); } }
#pragma unroll
    for (int k = 0; k < 2; ++k) { const int it = tid + k * NTHREADS, e = it - 16, dr = e >> 5, dc = e & 31;
        tr[k] = (it >= B_TREAL) ? -INFINITY : ((e >= 0 && dr < 15 && dc < 31) ? rpb[h * 465 + dr * 31 + dc] * LOG2E : 0.f); }
}
__device__ __forceinline__ void attn_b_commit(LAS unsigned char* lds, const v4u (&kr)[9], const v4u (&vr)[9], const float (&tr)[2]) {
    const int tid = threadIdx.x; LAS unsigned char* Kl = lds + B_KOFF; LAS unsigned char* Vl = lds + B_VOFF; LAS float* T = (LAS float*)(lds + B_TOFF);
#pragma unroll
    for (int k = 0; k < 9; ++k) { const int it = tid + k * NTHREADS; const int row = it >> 3, ch = it & 7;
        *(LAS v4u*)(Kl + swz(row, ch)) = kr[k]; *(LAS v4u*)(Vl + swz(row, ch)) = vr[k]; }
#pragma unroll
    for (int k = 0; k < 2; ++k) { const int it = tid + k * NTHREADS; if (it < B_TSIZE) T[it] = tr[k]; }
}
__device__ __forceinline__ void attn_b_unit(LAS unsigned char* lds, const bf16* Z, bf16* Y, int unit) {
    const int tid = threadIdx.x, lane = tid & 63, wid = tid >> 6, lq = lane & 15, g = lane >> 4;
    const int rp = unit & 63, h = (unit >> 6) & 7, b = unit >> 9;
    const size_t tok0 = (size_t)b * SEQ;
    const int R0 = clampi(2 * rp - 4, 0, 120);
    LAS unsigned char* Kl = lds + B_KOFF; LAS unsigned char* Vl = lds + B_VOFF; LAS float* T = (LAS float*)(lds + B_TOFF);
    const int rq = 2 * rp + (wid >> 2), cb = wid & 3, c = 16 * cb + lq;
    const int r0q = clampi(rq - 4, 0, 120), kc0 = clampi(16 * cb - 8, 0, 32), cs = clampi(c - 8, 0, 48);
    const size_t qtok = tok0 + (size_t)rq * 64 + c;
    const unsigned char* qp = (const unsigned char*)Z + tmo((int)qtok, Z_QB / 64 + h, ZLD / 64) + 16 * g;
    const bf16x8 qf0 = *(const bf16x8*)qp, qf1 = *(const bf16x8*)(qp + 64);
    float m0 = -1e30f, l0 = 0.f, m1 = -1e30f, l1 = 0.f;
    f32x4 O0[4], O1[4];
#pragma unroll
    for (int d = 0; d < 4; ++d) { O0[d] = (f32x4){0.f, 0.f, 0.f, 0.f}; O1[d] = (f32x4){0.f, 0.f, 0.f, 0.f}; }
    const int kcl = kc0 + 4 * g;
    const int tb = 16 + (kcl - c + 15);
    const int Rb = (r0q - R0) * 64 + kc0;
    const LAS unsigned char* kp0 = Kl + swz(Rb + lq, g); const LAS unsigned char* kp1 = Kl + swz(Rb + lq, 4 + g);
    const LAS unsigned char* vp[4];
    { const int i = lane & 15, rq4 = i >> 2, p = i & 3;
#pragma unroll
      for (int db = 0; db < 4; ++db) vp[db] = Vl + swz(Rb + 4 * g + rq4, 2 * db + (p >> 1)) + 8 * (p & 1); }
    const LAS float* T0 = T + tb + (r0q - rq + 7) * 32;
    const LAS float* tpa[4]; const LAS float* tpb[4];
#pragma unroll
    for (int r = 0; r < 4; ++r) { const int kca = kcl + r, kcb = kca + 16;
        tpa[r] = (kca >= cs && kca <= cs + 15) ? T0 + r : T + B_TREAL; tpb[r] = (kcb >= cs && kcb <= cs + 15) ? T0 + 16 + r : T + B_TREAL; }
#pragma unroll
    for (int st = 0; st < 4; ++st) {
        const int offA = st * 8192, offB = offA + 4 * 8192;
        f32x4 SA0, SA1, SB0, SB1;
        qk_at(kp0, kp1, offA, qf0, qf1, SA0, SA1);
        qk_at(kp0, kp1, offB, qf0, qf1, SB0, SB1);
#pragma unroll
        for (int r = 0; r < 4; ++r) {
            SA0[r] += tpa[r][st * 32]; SA1[r] += tpb[r][st * 32]; SB0[r] += tpa[r][st * 32 + 128]; SB1[r] += tpb[r][st * 32 + 128];
        }
        softmax_step(SA0, SA1, m0, l0, O0);
        softmax_step(SB0, SB1, m1, l1, O1);
        pv_at(vp, offA, SA0, SA1, O0);
        pv_at(vp, offB, SB0, SB1, O1);
    }
    { const float mm = fmaxf(m0, m1), a0 = __builtin_amdgcn_exp2f(m0 - mm), a1 = __builtin_amdgcn_exp2f(m1 - mm);
      l0 = l0 * a0 + l1 * a1;
#pragma unroll
      for (int d = 0; d < 4; ++d) O0[d] = O0[d] * a0 + O1[d] * a1; }
    store_o((bf16*)((unsigned char*)Y + tmo((int)qtok, 8 + h, 16)), g, l0, O0);
}

#define XB_TMO      128
#define XB_XCNT(j)  (256  + 64 * (j))
#define XB_XSUB(j)  (1280 + 64 * (j))
#define XB_XGEN(j)  (2304 + 64 * (j))
#define XB_TOP      3328
#define XB_TOPGEN   3392
#define XCD_BAR_WORDS 3456
#define XB_SPIN_CAP (1u << 18)

__device__ __forceinline__ unsigned xb_ld(unsigned* p)              { return __hip_atomic_load(p, __ATOMIC_RELAXED, __HIP_MEMORY_SCOPE_AGENT); }
__device__ __forceinline__ unsigned xb_add(unsigned* p, unsigned v) { return __hip_atomic_fetch_add(p, v, __ATOMIC_RELAXED, __HIP_MEMORY_SCOPE_AGENT); }
__device__ __forceinline__ unsigned xb_xcc_id() { return (unsigned)__builtin_amdgcn_s_getreg((3 << 11) | 20) & 0xFu; }
#define XB_SPIN(cond, bar) do { unsigned _sp = 0; while (cond) { __builtin_amdgcn_s_sleep(1); \
    if ((++_sp & 255u) == 0u) { if (xb_ld(&(bar)[XB_TMO])) break; if (_sp > XB_SPIN_CAP) { atomicAdd(&(bar)[XB_TMO], 1u); break; } } } } while (0)

struct XcdBarrier {
    unsigned* bar; unsigned x;
    volatile LAS unsigned* st;
};

__device__ __forceinline__ XcdBarrier xcd_barrier_post(unsigned* bar, volatile LAS unsigned* st) {
    XcdBarrier b; b.bar = bar; b.x = xb_xcc_id(); b.st = st;
    if (threadIdx.x == 0) (void)xb_add(&bar[XB_XCNT(b.x)], 1u);
    return b;
}
__device__ __forceinline__ void xcd_barrier_complete(unsigned* bar, unsigned x, unsigned& nloc, unsigned& nx) {
    const unsigned G = gridDim.x * gridDim.y * gridDim.z;
    unsigned sum, cnt, mine, sp = 0u;
    for (;;) {
        sum = 0u; cnt = 0u; mine = 0u;
#pragma unroll
        for (unsigned j = 0; j < 16; ++j) { const unsigned c = xb_ld(&bar[XB_XCNT(j)]); sum += c; cnt += (c > 0u) ? 1u : 0u; mine = (j == x) ? c : mine; }
        if (sum == G) break;
        __builtin_amdgcn_s_sleep(1);
        if ((++sp & 255u) == 0u) { if (xb_ld(&bar[XB_TMO])) break; if (sp > XB_SPIN_CAP) { atomicAdd(&bar[XB_TMO], 1u); break; } }
    }
    nloc = mine > 0u ? mine : 1u; nx = cnt > 0u ? cnt : 1u;
}

__device__ __forceinline__ void xcd_barrier(const XcdBarrier& b) {
    asm volatile("s_waitcnt vmcnt(0)" ::: "memory");
    __syncthreads();
    if (threadIdx.x == 0) {
        unsigned* bar = b.bar;
        __builtin_amdgcn_s_waitcnt(0);
        unsigned nloc = b.st[0], nx = b.st[1];
        if (nloc == 0u) { xcd_barrier_complete(bar, b.x, nloc, nx); b.st[0] = nloc; b.st[1] = nx; }
        const unsigned old = xb_add(&bar[XB_XSUB(b.x)], 1u);
        const unsigned gen = old / nloc;
        if (old + 1u == (gen + 1u) * nloc) {
            __builtin_amdgcn_fence(__ATOMIC_RELEASE, "agent");
            asm volatile("s_waitcnt vmcnt(0)" ::: "memory");
            const unsigned og = xb_add(&bar[XB_TOP], 1u);
            const unsigned tg = og / nx;
            if (og + 1u == (tg + 1u) * nx) xb_add(&bar[XB_TOPGEN], 1u);
            else XB_SPIN(xb_ld(&bar[XB_TOPGEN]) == tg, bar);
            __builtin_amdgcn_fence(__ATOMIC_ACQUIRE, "agent");
            xb_add(&bar[XB_XGEN(b.x)], 1u);
            asm volatile("s_waitcnt vmcnt(0)" ::: "memory");
        } else {
            XB_SPIN(xb_ld(&bar[XB_XGEN(b.x)]) == gen, bar);
            __builtin_amdgcn_fence(__ATOMIC_ACQUIRE, "agent");
            asm volatile("s_waitcnt vmcnt(0)" ::: "memory");
        }
    }
    __syncthreads();
}

struct Args { const float* in[13]; float* out; unsigned char* ws; int ph_lo, ph_hi; };
constexpr int N_PHASES = 8;
__global__ void __launch_bounds__(NTHREADS, 2) mk_fwd(Args args) {
    extern __shared__ __attribute__((aligned(16))) unsigned char lds_raw[];
    LAS unsigned char* lds = (LAS unsigned char*)lds_raw;
    const int tid = threadIdx.x, lane = tid & 63, wave = __builtin_amdgcn_readfirstlane(tid >> 6);
    const int G = gridDim.x, bx = blockIdx.x;
    const int vcu = (G % 8 == 0) ? (bx % 8) * (G / 8) + bx / 8 : bx;
    unsigned char* ws = args.ws;
    const float* x = args.in[0]; const float* norm_mix = args.in[1]; const float* w_in = args.in[2]; const float* b_gate = args.in[3];
    const float* sink = args.in[4]; const float* rpb = args.in[5]; const float* w_pa = args.in[6]; const float* w_pb = args.in[7];
    const float* w_out = args.in[8]; const float* norm_mlp = args.in[9]; const float* w_up = args.in[10]; const float* w_dn = args.in[11]; const float* norm_final = args.in[12];
    float* out = args.out;
    float* ss1 = (float*)(ws + WS_SS1); float* ss2 = (float*)(ws + WS_SS2); unsigned* cnt6 = (unsigned*)(ws + WS_CNT);
    bf16 *Win_t = (bf16*)(ws + WS_WIN), *Wpa_t = (bf16*)(ws + WS_WPA), *Wpb_t = (bf16*)(ws + WS_WPB), *Wout_t = (bf16*)(ws + WS_WOUT), *Wup_t = (bf16*)(ws + WS_WUP), *Wdn_t = (bf16*)(ws + WS_WDN);
    bf16 *XN = (bf16*)(ws + WS_XN), *YA = (bf16*)(ws + WS_YA), *YB = (bf16*)(ws + WS_YB), *MG = (bf16*)(ws + WS_MG), *X2 = (bf16*)(ws + WS_X2), *Zb = (bf16*)(ws + WS_Z), *Hb = (bf16*)(ws + WS_Z);
    const int lo = args.ph_lo, hi = args.ph_hi;
    volatile LAS unsigned* bst = (volatile LAS unsigned*)(lds + LDS_BYTES - 16);
    if (tid < 4) bst[tid] = 0u;
    __syncthreads();
    XcdBarrier bar = xcd_barrier_post((unsigned*)(ws + WS_BAR), bst);
#define IN(k) (lo <= (k) && (k) < hi)
#define SEAM(k) do { if (IN(k) && IN((k) + 1)) { if (hi > N_PHASES) cg::this_grid().sync(); else xcd_barrier(bar); } } while (0)

    if (IN(0)) {
        LAS float* scr = (LAS float*)(lds + wave * 16384);
        const int gw = vcu * NWAVES + wave, NGW = G * NWAVES;
        constexpr int I_IN = (DM / 64) * (ZLD / 32), I_P = (512 / 64) * (DM / 32), I_O = (DM / 64) * (DM / 32), I_U = (DM / 64) * (FF / 32), I_D = (FF / 64) * (DM / 32);
        constexpr int NITEMS = I_IN + 2 * I_P + I_O + I_U + I_D;
        for (int it = gw; it < NITEMS; it += NGW) {
            int r = it;
            if (r < I_IN) { p0_transpose_item(w_in, DM, ZLD, Win_t, scr, r, lane); continue; } r -= I_IN;
            if (r < I_P) { p0_transpose_item(w_pa, 512, DM, Wpa_t, scr, r, lane, nullptr, 1024, 0); continue; } r -= I_P;
            if (r < I_P) { p0_transpose_item(w_pb, 512, DM, Wpa_t, scr, r, lane, nullptr, 1024, 512); continue; } r -= I_P;
            if (r < I_O) { p0_transpose_item(w_out, DM, DM, Wout_t, scr, r, lane); continue; } r -= I_O;
            if (r < I_U) { p0_transpose_item(w_up, DM, FF, Wup_t, scr, r, lane, norm_mlp); continue; } r -= I_U;
            p0_transpose_item(w_dn, FF, DM, Wdn_t, scr, r, lane);
        }
        for (int i = bx * NTHREADS + tid; i < M; i += G * NTHREADS) { ss1[i] = 0.f; ss2[i] = 0.f; if (i < 256 * 16) cnt6[i] = 0u; }
        {
            const f32x4* gr = (const f32x4*)norm_mix + lane; f32x4 gg[4];
#pragma unroll
            for (int j = 0; j < 4; ++j) gg[j] = gr[64 * j];
            for (int mrow = gw; mrow < M; mrow += 4 * NGW) {
                f32x4 v[4][4]; float ssq[4];
#pragma unroll
                for (int r = 0; r < 4; ++r) { const f32x4* xr = (const f32x4*)(x + (size_t)min(mrow + r * NGW, M - 1) * DM) + lane;
#pragma unroll
                    for (int j = 0; j < 4; ++j) v[r][j] = __builtin_nontemporal_load(xr + 64 * j); }
#pragma unroll
                for (int r = 0; r < 4; ++r) { float t = 0.f;
#pragma unroll
                    for (int j = 0; j < 4; ++j) t += (v[r][j].x * v[r][j].x + v[r][j].y * v[r][j].y) + (v[r][j].z * v[r][j].z + v[r][j].w * v[r][j].w);
                    ssq[r] = t; }
#pragma unroll
                for (int o = 1; o < 64; o <<= 1) {
#pragma unroll
                    for (int r = 0; r < 4; ++r) ssq[r] += __shfl_xor(ssq[r], o); }
#pragma unroll
                for (int r = 0; r < 4; ++r) { const float rstd = 1.0f / sqrtf(ssq[r] * (1.f / DM) + EPS);
                    unsigned char* o8 = (unsigned char*)XN + tmo(min(mrow + r * NGW, M - 1), lane >> 4, 16) + 8 * (lane & 15);
#pragma unroll
                    for (int j = 0; j < 4; ++j) { const f32x4 t = v[r][j] * rstd * gg[j]; *(unsigned long long*)(o8 + (size_t)j * 4 * 32768) = (unsigned long long)pk2(t.x, t.y) | ((unsigned long long)pk2(t.z, t.w) << 32); } }
            }
        }
        __syncthreads();
    }
    SEAM(0);
    if (IN(1)) {
        pg8::Gemm g{XN, Win_t, M, ZLD, DM}; pg8::StaticOrder S; S.init(M, ZLD, G, bx);
        pg8::EpiPlain E{Zb, ZLD / 64, lds + 131072};
        pg8::gemm_phase<pg8::EpiPlain, pg8::StaticOrder, PG8_ALIGN, PG8_SP2>(lds, g, S, E);
    }
    SEAM(1);
    if (IN(2)) {
        {
            v4u kr[7], vr[7]; int u = vcu; const int NU = BATCH * 2 * 64;
            if (u < NU) attn_a_prefetch(Zb, u, kr, vr);
            for (; u < NU; u += G) {
                attn_a_commit(lds, kr, vr);
                __syncthreads();
                if (u + G < NU) attn_a_prefetch(Zb, u + G, kr, vr);
                asm volatile("" ::: "memory");
                attn_a_unit(lds, Zb, YA, sink, u);
                __syncthreads();
            }
        }
        {
            v4u kr[9], vr[9]; float tr[2]; int u = vcu; const int NU = BATCH * 8 * 64;
            if (u < NU) attn_b_prefetch(Zb, rpb, u, kr, vr, tr);
            for (; u < NU; u += G) {
                attn_b_commit(lds, kr, vr, tr);
                __syncthreads();
                if (u + G < NU) attn_b_prefetch(Zb, rpb, u + G, kr, vr, tr);
                asm volatile("" ::: "memory");
                attn_b_unit(lds, Zb, YA, u);
                __syncthreads();
            }
        }
    }
    SEAM(2);
    if (IN(3)) {
        pg8::Gemm g{YA, Wpa_t, M, DM, DM}; pg8::StaticOrder S; S.init(M, DM, G, bx);
        pg8::EpiGate2 E{MG, Zb, ZLD / 64, Z_GA / 64, Z_GB / 64, b_gate, lds + 131072};
        pg8::gemm_phase<pg8::EpiGate2, pg8::StaticOrder, PG8_ALIGN, PG8_SP2>(lds, g, S, E);
    }
    SEAM(3);
    if (IN(4)) {
        pg8::Gemm g{MG, Wout_t, M, DM, DM}; pg8::StaticOrder S; S.init(M, DM, G, bx);
        pg8::EpiRes1 E{x, XN, ss1, lds + 131072};
        pg8::gemm_phase<pg8::EpiRes1, pg8::StaticOrder, PG8_ALIGN, PG8_SP2>(lds, g, S, E);
    }
    SEAM(4);
    if (IN(5)) {
        pg8::Gemm g{XN, Wup_t, M, FF, DM}; pg8::StaticOrder S; S.init(M, FF, G, bx);
        pg8::EpiUp E{Hb, ss1, EPS, lds + 131072};
        pg8::gemm_phase<pg8::EpiUp, pg8::StaticOrder, PG8_ALIGN, PG8_SP2>(lds, g, S, E);
    }
    SEAM(5);
    if (IN(6)) {
        pg8::Gemm g{Hb, Wdn_t, M, DM, FF}; pg8::StaticOrder S; S.init(M, DM, G, bx);
        if (G == 256 && hi == N_PHASES && PG8_ALIGN) { pg8::EpiResNorm E{XN, out, norm_final, ss2, cnt6, EPS, lds + 131072};
            pg8::gemm_phase<pg8::EpiResNorm, pg8::StaticOrder, PG8_ALIGN, PG8_SP2>(lds, g, S, E); }
        else { pg8::EpiRes2 E{XN, X2, ss2, lds + 131072};
            pg8::gemm_phase<pg8::EpiRes2, pg8::StaticOrder, PG8_ALIGN, PG8_SP2>(lds, g, S, E); }
    }
    const bool fusedNorm = (G == 256 && hi == N_PHASES && PG8_ALIGN);
    if (!fusedNorm) SEAM(6);
    if (IN(7) && !fusedNorm) {
        const int gw = vcu * NWAVES + wave, NGW = G * NWAVES;
        const f32x4* gr = (const f32x4*)norm_final + lane;
        f32x4 gg[4];
#pragma unroll
        for (int j = 0; j < 4; ++j) gg[j] = gr[64 * j];
        for (int mrow = 4 * gw; mrow < M; mrow += 4 * NGW) {
            v2u xv[4][4]; float rstd[4];
#pragma unroll
            for (int r = 0; r < 4; ++r) { const unsigned char* xr = (const unsigned char*)X2 + tmo(mrow + r, lane >> 4, 16) + 8 * (lane & 15);
                rstd[r] = __hip_atomic_load(ss2 + mrow + r, __ATOMIC_RELAXED, __HIP_MEMORY_SCOPE_AGENT);
#pragma unroll
                for (int j = 0; j < 4; ++j) xv[r][j] = __builtin_nontemporal_load((const v2u*)(xr + (size_t)j * 4 * 32768)); }
#pragma unroll
            for (int r = 0; r < 4; ++r) { const float rs = 1.0f / sqrtf(rstd[r] * (1.f / DM) + EPS); f32x4* orow = (f32x4*)(out + (size_t)(mrow + r) * DM) + lane;
#pragma unroll
                for (int j = 0; j < 4; ++j) { const f32x4 v = {__uint_as_float(xv[r][j].x << 16), __uint_as_float(xv[r][j].x & 0xffff0000u), __uint_as_float(xv[r][j].y << 16), __uint_as_float(xv[r][j].y & 0xffff0000u)};
                    __builtin_nontemporal_store(v * rs * gg[j], orow + 64 * j); } }
        }
    }
#undef IN
#undef SEAM
}

extern "C" void kernel_launch(void* const* d_in, const int* in_sizes, int n_in, void* d_out, int out_size, void* d_ws, size_t ws_size, hipStream_t stream) {
    static int grid = 0;
    if (grid == 0) {
        if (n_in != 13 || in_sizes[0] != M * DM || out_size != M * DM || ws_size < WS_END) { fprintf(stderr, "kernel_launch: unexpected shapes (n_in %d in0 %d out %d ws %zu)\n", n_in, n_in > 0 ? in_sizes[0] : -1, out_size, ws_size); grid = -1; return; }
        int dev = 0, cus = 0, per_cu = 0;
        if (hipGetDevice(&dev) != hipSuccess || hipDeviceGetAttribute(&cus, hipDeviceAttributeMultiprocessorCount, dev) != hipSuccess) { grid = -1; return; }
        if (hipFuncSetAttribute((const void*)mk_fwd, hipFuncAttributeMaxDynamicSharedMemorySize, LDS_BYTES) != hipSuccess) { fprintf(stderr, "kernel_launch: hipFuncSetAttribute failed\n"); grid = -1; return; }
        if (hipOccupancyMaxActiveBlocksPerMultiprocessor(&per_cu, (const void*)mk_fwd, NTHREADS, LDS_BYTES) != hipSuccess || per_cu < 1) { fprintf(stderr, "kernel_launch: occupancy query says %d\n", per_cu); per_cu = 1; }
        (void)hipGetLastError();
        grid = cus * per_cu;
    }
    if (grid < 0) return;
    if (hipMemsetAsync((char*)d_ws + WS_BAR, 0, WS_BAR_BYTES, stream) != hipSuccess) { fprintf(stderr, "kernel_launch: hipMemsetAsync failed\n"); return; }
    Args a{};
    for (int i = 0; i < 13; ++i) a.in[i] = (const float*)d_in[i];
    a.out = (float*)d_out; a.ws = (unsigned char*)d_ws;
#if MK_MULTI
    for (int p = 0; p < N_PHASES; ++p) { a.ph_lo = p; a.ph_hi = p + 1; hipLaunchKernelGGL(mk_fwd, dim3(grid), dim3(NTHREADS), LDS_BYTES, stream, a); }
#else
    a.ph_lo = 0; a.ph_hi = N_PHASES;
    void* kargs[] = {&a};
    hipError_t e = hipLaunchCooperativeKernel((const void*)mk_fwd, dim3(grid), dim3(NTHREADS), kargs, LDS_BYTES, stream);
    if (e != hipSuccess) fprintf(stderr, "cooperative launch failed: %s (grid %d)\n", hipGetErrorString(e), grid);
#endif
}
```

```cpp
#include <hip/hip_runtime.h>
#include <hip/hip_cooperative_groups.h>
#include <cstdio>
#include <cstdint>
namespace cg = cooperative_groups;
namespace pg8 {
#define PG8_LAS __attribute__((address_space(3)))
typedef unsigned short bf16_t;
typedef short bf16x8 __attribute__((ext_vector_type(8)));
typedef float f32x4 __attribute__((ext_vector_type(4)));
typedef unsigned u32x4 __attribute__((ext_vector_type(4)));
constexpr int BM = 256, BK = 64, HALF = 128, HTB = HALF * BK * 2  , STAGE_BYTES = 8 * HTB, NXCD = 8, WGM = 8;

__host__ __device__ __forceinline__ int lds_byte(int r, int c) { const int st = (r >> 4) * 2 + (c >> 5), rr = r & 15, cc = c & 31, ob = rr * 64 + cc * 2; return st * 1024 + (ob ^ (((ob >> 9) & 1) << 5)); }
__host__ __device__ __forceinline__ void stage_rc(int b, int& R, int& C) { const int st = b / 1024, sb = b % 1024, swz = sb ^ (((sb >> 9) & 1) << 5); R = (st >> 1) * 16 + swz / 64; C = (st & 1) * 32 + (swz % 64) / 2; }
__host__ __device__ __forceinline__ int perm32(int rho) { const int n = rho >> 4, i = rho & 15; return 8 * (i >> 2) + 4 * n + (i & 3); }

struct Unit { int pm, pn; };
struct Gemm { const bf16_t* A; const bf16_t* Bt; int M, N, K; };

struct StaticOrder {
    int nM, nN, nwg, G, c;
    __host__ __device__ void init(int M, int N, int G_, int c_) { nM = M / BM; nN = N / BM; nwg = nM * nN; G = G_; c = c_; }
    __host__ __device__ bool next(int i, Unit& u) const {
        const long L = (long)i * G + c; if (L >= nwg) return false;
        int wgid = (int)L; { const int q = nwg / NXCD, r = nwg % NXCD, xcd = wgid % NXCD, off = wgid / NXCD; wgid = (xcd < r ? xcd * (q + 1) : r * (q + 1) + (xcd - r) * q) + off; }
        const int nig = WGM * nN, gid = wgid / nig, fm = gid * WGM, gsz = (nM - fm) < WGM ? (nM - fm) : WGM;
        u.pm = fm + ((wgid % nig) % gsz); u.pn = (wgid % nig) / gsz; return true;
    }
    __device__ __forceinline__ void a_ready(const Unit&) const {}
    __device__ __forceinline__ void done(const Unit&) const {}
};

__device__ __forceinline__ unsigned cvt_pk_bf16(float lo, float hi) { unsigned r; asm volatile("v_cvt_pk_bf16_f32 %0, %1, %2" : "=v"(r) : "v"(lo), "v"(hi)); return r; }
typedef float f32x2 __attribute__((ext_vector_type(2)));
typedef unsigned u32x2 __attribute__((ext_vector_type(2)));
__device__ __forceinline__ float bf_lo(unsigned w) { return __uint_as_float(w << 16); }
__device__ __forceinline__ float bf_hi(unsigned w) { return __uint_as_float(w & 0xffff0000u); }
__device__ __forceinline__ size_t tm_block(int pm, int ct, int nct) { return ((size_t)pm * nct + ct) * 32768; }
__device__ __forceinline__ int tm_lane(int wr, int fr, int fq) { return (wr * 64 + fr) * 128 + fq * 16; }
#define TM_PIECE(ai, m, bj) ((ai) * 16384 + (m) * 2048 + (bj) * 64)
__device__ __forceinline__ u32x4 pack8(const f32x4& v0, const f32x4& v1) { u32x4 w; w.x = cvt_pk_bf16(v0[0], v0[1]); w.y = cvt_pk_bf16(v0[2], v0[3]); w.z = cvt_pk_bf16(v1[0], v1[1]); w.w = cvt_pk_bf16(v1[2], v1[3]); return w; }
#define UNPK0(q_) ((f32x4){bf_lo((q_).x), bf_hi((q_).x), bf_lo((q_).y), bf_hi((q_).y)})
#define UNPK1(q_) ((f32x4){bf_lo((q_).z), bf_hi((q_).z), bf_lo((q_).w), bf_hi((q_).w)})

#define PG8_SCR_STRIDE 144
#define PG8_SCR_WAVE 2304
struct PieceOut { PG8_LAS unsigned char* wp; const PG8_LAS unsigned char* rp; unsigned char* ob;
    __device__ __forceinline__ PieceOut(PG8_LAS unsigned char* scr, void* O, size_t block, int wr, int wc, int fr, int fq) {
        const int lane = fq * 16 + fr; PG8_LAS unsigned char* my = scr + (wr * 4 + wc) * PG8_SCR_WAVE;
        wp = my + fr * PG8_SCR_STRIDE + fq * 16; rp = my + (lane >> 3) * PG8_SCR_STRIDE + (lane & 7) * 16; ob = (unsigned char*)O + block + (size_t)(wr * 64) * 128 + lane * 16; }
    __device__ __forceinline__ void put(int bj, const u32x4& w) const { *(PG8_LAS u32x4*)(wp + bj * 64) = w; }
    template <bool NT> __device__ __forceinline__ void flush(int ai, int m) const {
        const u32x4 r0 = *(const PG8_LAS u32x4*)rp, r1 = *(const PG8_LAS u32x4*)(rp + 8 * PG8_SCR_STRIDE);
        u32x4* p = (u32x4*)(ob + ai * 16384 + m * 2048);
        if (NT) { __builtin_nontemporal_store(r0, p); __builtin_nontemporal_store(r1, p + 64); } else { *p = r0; *(p + 64) = r1; } }
};
struct PieceIn { PG8_LAS unsigned char* wp; PG8_LAS unsigned char* rp; const unsigned char* ib;
    __device__ __forceinline__ PieceIn(PG8_LAS unsigned char* scr, const void* I, size_t block, int wr, int wc, int fr, int fq) {
        const int lane = fq * 16 + fr; PG8_LAS unsigned char* my = scr + (wr * 4 + wc) * PG8_SCR_WAVE;
        wp = my + fr * PG8_SCR_STRIDE + fq * 16; rp = my + (lane >> 3) * PG8_SCR_STRIDE + (lane & 7) * 16; ib = (const unsigned char*)I + block + (size_t)(wr * 64) * 128 + lane * 16; }
    __device__ __forceinline__ void fetch(int ai, int m, u32x4& raw0, u32x4& raw1) const { const u32x4* p = (const u32x4*)(ib + ai * 16384 + m * 2048); raw0 = *p; raw1 = *(p + 64); }
    __device__ __forceinline__ void stage(const u32x4& raw0, const u32x4& raw1) const { *(PG8_LAS u32x4*)rp = raw0; *(PG8_LAS u32x4*)(rp + 8 * PG8_SCR_STRIDE) = raw1; }
    __device__ __forceinline__ u32x4 get(int bj) const { return *(const PG8_LAS u32x4*)(wp + bj * 64); }
};
struct EpiPlain {
    static constexpr bool PERM = true, AFTER_DRAIN = false, HAS_MID = false, HAS_PRE = false;
    bf16_t* O; int nct; PG8_LAS unsigned char* scr;
    __device__ __forceinline__ void operator()(const f32x4 (&acc)[2][2][4][2], const Unit& u, int wr, int wc, int fr, int fq) const {
        const PieceOut po(scr, O, tm_block(u.pm, u.pn * 4 + wc, nct), wr, wc, fr, fq);
        const float qs = (u.pn < 2 || u.pn == 3 || u.pn == 4) ? 0.125f * 1.4426950408889634f : 1.0f;
#pragma unroll
        for (int ai = 0; ai < 2; ++ai)
#pragma unroll
            for (int m = 0; m < 4; ++m) { po.put(0, pack8(acc[ai][0][m][0] * qs, acc[ai][0][m][1] * qs)); po.put(1, pack8(acc[ai][1][m][0] * qs, acc[ai][1][m][1] * qs)); po.flush<true>(ai, m); }
    }
};
struct EpiGate2 {
    static constexpr bool PERM = true, AFTER_DRAIN = false, HAS_MID = true, HAS_PRE = false;
    bf16_t* O; const bf16_t* Z; int znct; int ga_ct, gb_ct; const float* bg; PG8_LAS unsigned char* scr;
    static __device__ __forceinline__ float eneg(float g) { return __builtin_amdgcn_exp2f(-1.4426950408889634f * fminf(fmaxf(g, -30.f), 30.f)); }
    __device__ __forceinline__ void mid(f32x4 (&acc)[2][2][4][2], const Unit& u, int wr, int wc, int fr, int fq) const {
        int pm = u.pm, cb = u.pn * 4 + wc;
        asm volatile("" : "+v"(pm), "+v"(cb));
        const PieceIn pa(scr, Z, tm_block(pm, ga_ct + cb, znct), wr, wc, fr, fq), pb(scr, Z, tm_block(pm, gb_ct + cb, znct), wr, wc, fr, fq);
        const int col0 = cb * 64 + 8 * fq;
        f32x4 ba[2][2], bb[2][2];
#pragma unroll
        for (int bj = 0; bj < 2; ++bj) { ba[bj][0] = *(const f32x4*)(bg + col0 + bj * 32); ba[bj][1] = *(const f32x4*)(bg + col0 + bj * 32 + 4); bb[bj][0] = *(const f32x4*)(bg + 1024 + col0 + bj * 32); bb[bj][1] = *(const f32x4*)(bg + 1024 + col0 + bj * 32 + 4); }
#pragma unroll
        for (int am = 0; am < 4; ++am) { const int ai = am >> 1;
            u32x4 ra[4][2], rb[4][2];
#pragma unroll
            for (int m = 2 * (am & 1); m < 2 * (am & 1) + 2; ++m) { pa.fetch(ai, m, ra[m][0], ra[m][1]); pb.fetch(ai, m, rb[m][0], rb[m][1]); }
            asm volatile("" ::: "memory");
#pragma unroll
            for (int m = 2 * (am & 1); m < 2 * (am & 1) + 2; ++m) {
                pa.stage(ra[m][0], ra[m][1]); const u32x4 ga0 = pa.get(0), ga1 = pa.get(1);
                asm volatile("" ::: "memory");
                pb.stage(rb[m][0], rb[m][1]); const u32x4 gb0 = pb.get(0), gb1 = pb.get(1);
                asm volatile("" ::: "memory");
#pragma unroll
                for (int bj = 0; bj < 2; ++bj) { const u32x4 ga = bj ? ga1 : ga0, gb = bj ? gb1 : gb0;
                    const f32x4 a0 = UNPK0(ga) + ba[bj][0], a1 = UNPK1(ga) + ba[bj][1], b0 = UNPK0(gb) + bb[bj][0], b1 = UNPK1(gb) + bb[bj][1];
#pragma unroll
                    for (int k = 0; k < 4; ++k) { acc[ai][bj][m][0][k] *= (1.0f + eneg(b0[k])) * __builtin_amdgcn_rcpf(1.0f + eneg(a0[k]));
                                                  acc[ai][bj][m][1][k] *= (1.0f + eneg(b1[k])) * __builtin_amdgcn_rcpf(1.0f + eneg(a1[k])); } } }
        }
    }
    __device__ __forceinline__ void operator()(const f32x4 (&acc)[2][2][4][2], const Unit& u, int wr, int wc, int fr, int fq) const {
        const int cb = u.pn * 4 + wc, col0 = cb * 64 + 8 * fq;
        const PieceOut po(scr, O, tm_block(u.pm, cb, 16), wr, wc, fr, fq);
        const PieceIn pb(scr, Z, tm_block(u.pm, gb_ct + cb, znct), wr, wc, fr, fq);
        f32x4 bb[2][2];
#pragma unroll
        for (int bj = 0; bj < 2; ++bj) { bb[bj][0] = *(const f32x4*)(bg + 1024 + col0 + bj * 32); bb[bj][1] = *(const f32x4*)(bg + 1024 + col0 + bj * 32 + 4); }
        u32x4 rb[2][4][2];
#pragma unroll
        for (int ai = 0; ai < 2; ++ai)
#pragma unroll
            for (int m = 0; m < 4; ++m) pb.fetch(ai, m, rb[ai][m][0], rb[ai][m][1]);
        asm volatile("" ::: "memory");
#pragma unroll
        for (int ai = 0; ai < 2; ++ai)
#pragma unroll
            for (int m = 0; m < 4; ++m) {
                pb.stage(rb[ai][m][0], rb[ai][m][1]); const u32x4 gb0 = pb.get(0), gb1 = pb.get(1);
                asm volatile("" ::: "memory");
#pragma unroll
                for (int bj = 0; bj < 2; ++bj) { const u32x4 gb = bj ? gb1 : gb0;
                    const f32x4 b0 = UNPK0(gb) + bb[bj][0], b1 = UNPK1(gb) + bb[bj][1];
                    f32x4 v0 = acc[ai][bj][m][0], v1 = acc[ai][bj][m][1];
#pragma unroll
                    for (int k = 0; k < 4; ++k) { v0[k] *= __builtin_amdgcn_rcpf(1.0f + eneg(b0[k])); v1[k] *= __builtin_amdgcn_rcpf(1.0f + eneg(b1[k])); }
                    po.put(bj, pack8(v0, v1)); }
                po.flush<false>(ai, m);
                asm volatile("" ::: "memory"); }
    }
};
struct EpiRes1 {
    static constexpr bool PERM = true, AFTER_DRAIN = false, HAS_MID = false, HAS_PRE = false;
    const float* x; bf16_t* X1; float* ss; PG8_LAS unsigned char* scr;
    __device__ __forceinline__ void operator()(const f32x4 (&acc)[2][2][4][2], const Unit& u, int wr, int wc, int fr, int fq) const {
        const int row0 = u.pm * BM + wr * 64 + fr, col0 = u.pn * BM + wc * 64 + 8 * fq;
        const PieceOut po(scr, X1, tm_block(u.pm, u.pn * 4 + wc, 16), wr, wc, fr, fq);
#pragma unroll
        for (int ai = 0; ai < 2; ++ai) {
            f32x4 xv[4][2][2];
#pragma unroll
            for (int m = 0; m < 4; ++m) { const float* xp = x + (size_t)(row0 + ai * HALF + m * 16) * 1024 + col0;
#pragma unroll
                for (int bj = 0; bj < 2; ++bj) { xv[m][bj][0] = *(const f32x4*)(xp + bj * 32); xv[m][bj][1] = *(const f32x4*)(xp + bj * 32 + 4); } }
            asm volatile("" ::: "memory");
#pragma unroll
            for (int m = 0; m < 4; ++m) { const int row = row0 + ai * HALF + m * 16; float sq = 0.f;
#pragma unroll
                for (int bj = 0; bj < 2; ++bj) { const f32x4 o0 = xv[m][bj][0] + acc[ai][bj][m][0], o1 = xv[m][bj][1] + acc[ai][bj][m][1];
                    sq += ((o0[0] * o0[0] + o0[1] * o0[1]) + (o0[2] * o0[2] + o0[3] * o0[3])) + ((o1[0] * o1[0] + o1[1] * o1[1]) + (o1[2] * o1[2] + o1[3] * o1[3]));
                    po.put(bj, pack8(o0, o1)); }
                po.flush<false>(ai, m);
                sq += __shfl_xor(sq, 16); sq += __shfl_xor(sq, 32);
                if (fq == 0) atomicAdd(ss + row, sq); }
        }
    }
};
struct EpiRes2 {
    static constexpr bool PERM = true, AFTER_DRAIN = false, HAS_MID = false, HAS_PRE = false;
    const bf16_t* X1; bf16_t* X2; float* ss; PG8_LAS unsigned char* scr;
    __device__ __forceinline__ void operator()(const f32x4 (&acc)[2][2][4][2], const Unit& u, int wr, int wc, int fr, int fq) const {
        const int row0 = u.pm * BM + wr * 64 + fr;
        const size_t blk = tm_block(u.pm, u.pn * 4 + wc, 16);
        const PieceIn pi(scr, X1, blk, wr, wc, fr, fq); const PieceOut po(scr, X2, blk, wr, wc, fr, fq);
        u32x4 rx[2][4][2];
#pragma unroll
        for (int ai = 0; ai < 2; ++ai)
#pragma unroll
            for (int m = 0; m < 4; ++m) pi.fetch(ai, m, rx[ai][m][0], rx[ai][m][1]);
        asm volatile("" ::: "memory");
#pragma unroll
        for (int ai = 0; ai < 2; ++ai)
#pragma unroll
            for (int m = 0; m < 4; ++m) { const int row = row0 + ai * HALF + m * 16; float sq = 0.f;
                pi.stage(rx[ai][m][0], rx[ai][m][1]); const u32x4 x0 = pi.get(0), x1 = pi.get(1);
                asm volatile("" ::: "memory");
#pragma unroll
                for (int bj = 0; bj < 2; ++bj) { const u32x4 z4 = bj ? x1 : x0;
                    const f32x4 o0 = UNPK0(z4) + acc[ai][bj][m][0], o1 = UNPK1(z4) + acc[ai][bj][m][1];
                    sq += ((o0[0] * o0[0] + o0[1] * o0[1]) + (o0[2] * o0[2] + o0[3] * o0[3])) + ((o1[0] * o1[0] + o1[1] * o1[1]) + (o1[2] * o1[2] + o1[3] * o1[3]));
                    po.put(bj, pack8(o0, o1)); }
                po.flush<false>(ai, m);
                asm volatile("" ::: "memory");
                sq += __shfl_xor(sq, 16); sq += __shfl_xor(sq, 32);
                if (fq == 0) atomicAdd(ss + row, sq); }
    }
};
struct EpiResNorm {
    static constexpr bool PERM = true, AFTER_DRAIN = false, HAS_MID = false, HAS_PRE = false;
    const bf16_t* X1; float* out; const float* gw; float* ss; unsigned* cnt; float eps; PG8_LAS unsigned char* scr;
    __device__ __forceinline__ void operator()(f32x4 (&acc)[2][2][4][2], const Unit& u, int wr, int wc, int fr, int fq) const {
        const int lane = fq * 16 + fr, row0 = u.pm * BM + wr * 64 + fr;
        const PieceIn pi(scr, X1, tm_block(u.pm, u.pn * 4 + wc, 16), wr, wc, fr, fq);
        u32x4 rx[2][4][2];
#pragma unroll
        for (int ai = 0; ai < 2; ++ai)
#pragma unroll
            for (int m = 0; m < 4; ++m) pi.fetch(ai, m, rx[ai][m][0], rx[ai][m][1]);
        asm volatile("" ::: "memory");
#pragma unroll
        for (int ai = 0; ai < 2; ++ai)
#pragma unroll
            for (int m = 0; m < 4; ++m) { const int row = row0 + ai * HALF + m * 16; float sq = 0.f;
                pi.stage(rx[ai][m][0], rx[ai][m][1]); const u32x4 x0 = pi.get(0), x1 = pi.get(1);
                asm volatile("" ::: "memory");
#pragma unroll
                for (int bj = 0; bj < 2; ++bj) { const u32x4 z4 = bj ? x1 : x0;
                    const f32x4 o0 = UNPK0(z4) + acc[ai][bj][m][0], o1 = UNPK1(z4) + acc[ai][bj][m][1];
                    acc[ai][bj][m][0] = o0; acc[ai][bj][m][1] = o1;
                    sq += ((o0[0] * o0[0] + o0[1] * o0[1]) + (o0[2] * o0[2] + o0[3] * o0[3])) + ((o1[0] * o1[0] + o1[1] * o1[1]) + (o1[2] * o1[2] + o1[3] * o1[3])); }
                sq += __shfl_xor(sq, 16); sq += __shfl_xor(sq, 32);
                if (fq == 0) atomicAdd(ss + row, sq); }
        asm volatile("s_waitcnt vmcnt(0)" ::: "memory");
        unsigned* c = cnt + 16 * u.pm;
        if (lane == 0) __hip_atomic_fetch_add(c, 1u, __ATOMIC_RELAXED, __HIP_MEMORY_SCOPE_AGENT);
        if (wr == 0 && wc == 0) { while (__hip_atomic_load(c, __ATOMIC_RELAXED, __HIP_MEMORY_SCOPE_AGENT) < 32u) __builtin_amdgcn_s_sleep(4); }
        asm volatile("s_waitcnt vmcnt(0) lgkmcnt(0)" ::: "memory"); __builtin_amdgcn_s_barrier(); asm volatile("" ::: "memory");
        float rs[2][4];
#pragma unroll
        for (int ai = 0; ai < 2; ++ai)
#pragma unroll
            for (int m = 0; m < 4; ++m) rs[ai][m] = __hip_atomic_load(ss + row0 + ai * HALF + m * 16, __ATOMIC_RELAXED, __HIP_MEMORY_SCOPE_AGENT);
        PG8_LAS unsigned char* my = scr + (wr * 4 + wc) * PG8_SCR_WAVE;
        PG8_LAS unsigned char* gp = my + fr * PG8_SCR_STRIDE + fq * 32;
        const PG8_LAS unsigned char* sp = my + (lane >> 3) * PG8_SCR_STRIDE + (lane & 7) * 16;
        float* ob = out + (size_t)(u.pm * BM + wr * 64 + (lane >> 3)) * 1024 + u.pn * BM + wc * 64 + (lane & 7) * 4;
        const int col0 = u.pn * BM + wc * 64 + 8 * fq;
#pragma unroll
        for (int bj = 0; bj < 2; ++bj) { const f32x4 g0 = *(const f32x4*)(gw + col0 + bj * 32), g1 = *(const f32x4*)(gw + col0 + bj * 32 + 4);
#pragma unroll
            for (int ai = 0; ai < 2; ++ai)
#pragma unroll
                for (int m = 0; m < 4; ++m) { const float r = __builtin_amdgcn_rsqf(rs[ai][m] * (1.0f / 1024.0f) + eps);
                    *(PG8_LAS f32x4*)gp = acc[ai][bj][m][0] * r * g0; *(PG8_LAS f32x4*)(gp + 16) = acc[ai][bj][m][1] * r * g1;
                    const f32x4 v0 = *(const PG8_LAS f32x4*)sp, v1 = *(const PG8_LAS f32x4*)(sp + 8 * PG8_SCR_STRIDE);
                    float* op = ob + (size_t)(ai * HALF + m * 16) * 1024 + bj * 32;
                    __builtin_nontemporal_store(v0, (f32x4*)op); __builtin_nontemporal_store(v1, (f32x4*)(op + 8 * 1024));
                    asm volatile("" ::: "memory"); } }
    }
};
struct EpiUp {
    static constexpr bool PERM = true, AFTER_DRAIN = false, HAS_MID = false, HAS_PRE = true;
    bf16_t* O; const float* ss; float eps; PG8_LAS unsigned char* scr;
    __device__ __forceinline__ void pre(float (&st)[8], const Unit& u, int wr, int wc, int fr, int fq) const {
        const float* sp = ss + u.pm * BM + wr * 64 + fr;
#pragma unroll
        for (int i = 0; i < 8; ++i) st[i] = sp[(i >> 2) * HALF + (i & 3) * 16];
    }
    __device__ __forceinline__ void post(const f32x4 (&acc)[2][2][4][2], const float (&st)[8], const Unit& u, int wr, int wc, int fr, int fq) const {
        const PieceOut po(scr, O, tm_block(u.pm, u.pn * 4 + wc, 64), wr, wc, fr, fq);
#pragma unroll
        for (int ai = 0; ai < 2; ++ai)
#pragma unroll
            for (int m = 0; m < 4; ++m) { const float rs = __builtin_amdgcn_rsqf(st[ai * 4 + m] * (1.0f / 1024.0f) + eps);
#pragma unroll
                for (int bj = 0; bj < 2; ++bj) { f32x4 v0 = acc[ai][bj][m][0] * rs, v1 = acc[ai][bj][m][1] * rs;
#pragma unroll
                    for (int k = 0; k < 4; ++k) { const float a = fmaxf(v0[k], 0.f), b = fmaxf(v1[k], 0.f); v0[k] = a * a; v1[k] = b * b; }
                    po.put(bj, pack8(v0, v1)); }
                po.flush<true>(ai, m); }
    }
};
template <class Epi, class Sched, bool ALIGN_EPI = false, bool SP2 = false>
__device__ __forceinline__ void gemm_phase(PG8_LAS unsigned char* lds, const Gemm g, const Sched& S, const Epi& E) {
    const int tid = threadIdx.x, wid = __builtin_amdgcn_readfirstlane(tid >> 6), lane = tid & 63, wr = wid >> 2, wc = wid & 3, fr = lane & 15, fq = lane >> 4;
    const int K = g.K, nt = K / BK;
    unsigned voffA[2], voffB[2];
#pragma unroll
    for (int i = 0; i < 2; ++i) { int R, C; stage_rc(tid * 16 + i * 8192, R, C); const int Rb = Epi::PERM ? (64 * (R >> 5) + perm32(R & 31)) : R;
        voffA[i] = (unsigned)(R * 64 + C) * 2u; voffB[i] = (unsigned)(Rb * 64 + C) * 2u; }
    const size_t kstep = (size_t)32768;
    const size_t hstep = (size_t)HALF * 128;
    const size_t tstep = (size_t)256 * K * 2; const size_t hstepB = Epi::PERM ? (size_t)32 * 128 : hstep;
    const unsigned ldsw = (unsigned)wid * 1024u;
    const int aoff = lds_byte(wr * 64 + fr, fq * 8), boff = lds_byte(wc * 32 + fr, fq * 8);
#define PG8_SA(b, h) (((b) * 2 + (h)) * HTB)
#define PG8_SB(b, h) ((4 + (b) * 2 + (h)) * HTB)
#define PG8_STAGE(bufoff, gbase, voff) do { _Pragma("unroll") for (int _i = 0; _i < 2; ++_i) \
        __builtin_amdgcn_global_load_lds((const unsigned*)((const char*)(gbase) + (voff)[_i]), (PG8_LAS unsigned*)(lds + (bufoff) + ldsw + _i * 8192), 16, 0, 0); } while (0)
#define PG8_LDA(dst, b, h) do { _Pragma("unroll") for (int m = 0; m < 4; ++m) _Pragma("unroll") for (int k = 0; k < 2; ++k) dst[m][k] = *(const PG8_LAS bf16x8*)(lds + PG8_SA(b, h) + aoff + m * 2048 + k * 1024); } while (0)
#define PG8_LDB(dst, b, h) do { _Pragma("unroll") for (int n = 0; n < 2; ++n) _Pragma("unroll") for (int k = 0; k < 2; ++k) dst[n][k] = *(const PG8_LAS bf16x8*)(lds + PG8_SB(b, h) + boff + n * 2048 + k * 1024); } while (0)
#define PG8_MMA(ai, bj, At, Bt) do { __builtin_amdgcn_s_setprio(1); _Pragma("unroll") for (int m = 0; m < 4; ++m) _Pragma("unroll") for (int n = 0; n < 2; ++n) _Pragma("unroll") for (int k = 0; k < 2; ++k) \
        acc[ai][bj][m][n] = __builtin_amdgcn_mfma_f32_16x16x32_bf16(Bt[n][k], At[m][k], acc[ai][bj][m][n], 0, 0, 0); __builtin_amdgcn_s_setprio(0); } while (0)
#define PG8_WAIT_V(n) asm volatile("s_waitcnt vmcnt(" #n ")" ::: "memory")
#define PG8_WAIT_L(n) asm volatile("s_waitcnt lgkmcnt(" #n ")" ::: "memory")
#define PG8_BAR __builtin_amdgcn_s_barrier()
#define PG8_SCHED __builtin_amdgcn_sched_barrier(0)
    Unit cur, nxt; int ui = 0;
    if (!S.next(0, cur)) return;
    f32x4 acc[2][2][4][2];
#pragma unroll
    for (int a = 0; a < 2; ++a)
#pragma unroll
        for (int b = 0; b < 2; ++b)
#pragma unroll
            for (int m = 0; m < 4; ++m)
#pragma unroll
                for (int n = 0; n < 2; ++n) acc[a][b][m][n] = (f32x4){0.f, 0.f, 0.f, 0.f};
    bf16x8 At[4][2], B0[2][2], B1[2][2];
    const char* cA = (const char*)g.A + (size_t)cur.pm * tstep; const char* cB = (const char*)g.Bt + (size_t)cur.pn * tstep;
    S.a_ready(cur);
    float pre_st[8];
    if constexpr (Epi::HAS_PRE) E.pre(pre_st, cur, wr, wc, fr, fq);
    if constexpr (SP2) {
        PG8_STAGE(PG8_SB(0, 0), cB, voffB); PG8_STAGE(PG8_SB(0, 1), cB + hstepB, voffB); PG8_STAGE(PG8_SA(0, 0), cA, voffA); PG8_STAGE(PG8_SA(0, 1), cA + hstep, voffA);
        if (wr == 1) PG8_BAR;
        PG8_WAIT_V(2); PG8_BAR;
        PG8_STAGE(PG8_SB(1, 0), cB + kstep, voffB); PG8_STAGE(PG8_SA(1, 0), cA + kstep, voffA); PG8_STAGE(PG8_SB(1, 1), cB + hstepB + kstep, voffB);
        PG8_WAIT_V(6); PG8_BAR;
    } else {
        PG8_STAGE(PG8_SB(0, 0), cB, voffB); PG8_STAGE(PG8_SA(0, 0), cA, voffA); PG8_STAGE(PG8_SB(0, 1), cB + hstepB, voffB); PG8_STAGE(PG8_SA(0, 1), cA + hstep, voffA);
        if (wr == 1) PG8_BAR;
        PG8_WAIT_V(4); PG8_BAR;
        PG8_STAGE(PG8_SB(1, 0), cB + kstep, voffB); PG8_STAGE(PG8_SA(1, 0), cA + kstep, voffA); PG8_STAGE(PG8_SB(1, 1), cB + hstepB + kstep, voffB);
        PG8_WAIT_V(6); PG8_BAR;
    }
    for (;;) {
        const bool has_next = S.next(ui + 1, nxt);
        const char* nA = has_next ? (const char*)g.A + (size_t)nxt.pm * tstep : cA; const char* nB = has_next ? (const char*)g.Bt + (size_t)nxt.pn * tstep : cB;
        for (int t = 0; t < nt; t += 2) {
            if constexpr (Epi::HAS_MID) { if (t == (nt >> 1)) E.mid(acc, cur, wr, wc, fr, fq); }
            const bool last = (t == nt - 2);
            const char* a1 = cA + (size_t)(t + 1) * kstep;
            const char* a2 = last ? nA : cA + (size_t)(t + 2) * kstep; const char* b2 = last ? nB : cB + (size_t)(t + 2) * kstep;
            const char* a3 = a2 + kstep; const char* b3 = b2 + kstep;
            if (last && has_next) S.a_ready(nxt);
            if constexpr (SP2) {
            PG8_LDB(B0, 0, 0); PG8_LDB(B1, 0, 1); PG8_SCHED; PG8_LDA(At, 0, 0); PG8_STAGE(PG8_SA(1, 1), a1 + hstep, voffA);
            PG8_WAIT_V(8); PG8_WAIT_L(0); PG8_BAR; PG8_MMA(0, 0, At, B0); PG8_MMA(0, 1, At, B1); PG8_BAR; PG8_SCHED;
            PG8_LDA(At, 0, 1); PG8_STAGE(PG8_SB(0, 0), b2, voffB); PG8_STAGE(PG8_SB(0, 1), b2 + hstepB, voffB); PG8_STAGE(PG8_SA(0, 0), a2, voffA);
            PG8_WAIT_V(8); PG8_WAIT_L(0); PG8_BAR; PG8_MMA(1, 0, At, B0); PG8_MMA(1, 1, At, B1); PG8_BAR; PG8_SCHED;
            PG8_LDB(B0, 1, 0); PG8_LDB(B1, 1, 1); PG8_SCHED; PG8_LDA(At, 1, 0); PG8_STAGE(PG8_SA(0, 1), a2 + hstep, voffA);
            PG8_WAIT_V(8); PG8_WAIT_L(0); PG8_BAR; PG8_MMA(0, 0, At, B0); PG8_MMA(0, 1, At, B1); PG8_BAR; PG8_SCHED;
            PG8_LDA(At, 1, 1); PG8_STAGE(PG8_SB(1, 0), b3, voffB); PG8_STAGE(PG8_SB(1, 1), b3 + hstepB, voffB); PG8_STAGE(PG8_SA(1, 0), a3, voffA);
            PG8_WAIT_V(8); PG8_WAIT_L(0); PG8_BAR; PG8_MMA(1, 0, At, B0); PG8_MMA(1, 1, At, B1); PG8_BAR; PG8_SCHED;
            } else {
            PG8_LDB(B0, 0, 0); PG8_SCHED; PG8_LDA(At, 0, 0); PG8_STAGE(PG8_SA(1, 1), a1 + hstep, voffA);
            PG8_WAIT_L(8); PG8_BAR; PG8_WAIT_L(0); PG8_MMA(0, 0, At, B0); PG8_BAR; PG8_SCHED;
            PG8_LDB(B1, 0, 1); PG8_STAGE(PG8_SB(0, 0), b2, voffB);
            PG8_BAR; PG8_WAIT_L(0); PG8_MMA(0, 1, At, B1); PG8_BAR;
            PG8_LDA(At, 0, 1); PG8_STAGE(PG8_SA(0, 0), a2, voffA);
            PG8_BAR; PG8_WAIT_L(0); PG8_MMA(1, 0, At, B0); PG8_BAR; PG8_SCHED;
            PG8_STAGE(PG8_SB(0, 1), b2 + hstepB, voffB);
            PG8_WAIT_V(6); PG8_BAR; PG8_MMA(1, 1, At, B1); PG8_BAR;
            PG8_LDB(B0, 1, 0); PG8_SCHED; PG8_LDA(At, 1, 0); PG8_STAGE(PG8_SA(0, 1), a2 + hstep, voffA);
            PG8_WAIT_L(8); PG8_BAR; PG8_WAIT_L(0); PG8_MMA(0, 0, At, B0); PG8_BAR; PG8_SCHED;
            PG8_LDB(B1, 1, 1); PG8_STAGE(PG8_SB(1, 0), b3, voffB);
            PG8_BAR; PG8_WAIT_L(0); PG8_MMA(0, 1, At, B1); PG8_BAR;
            PG8_LDA(At, 1, 1); PG8_STAGE(PG8_SA(1, 0), a3, voffA);
            PG8_BAR; PG8_WAIT_L(0); PG8_MMA(1, 0, At, B0); PG8_BAR; PG8_SCHED;
            PG8_STAGE(PG8_SB(1, 1), b3 + hstepB, voffB);
            PG8_WAIT_V(6); PG8_BAR; PG8_MMA(1, 1, At, B1); PG8_BAR;
            }
        }
        if constexpr (ALIGN_EPI) { if (wr == 0) PG8_BAR; }
        if constexpr (!Epi::AFTER_DRAIN) { if constexpr (Epi::HAS_PRE) { E.post(acc, pre_st, cur, wr, wc, fr, fq); if (has_next) E.pre(pre_st, nxt, wr, wc, fr, fq); } else E(acc, cur, wr, wc, fr, fq); S.done(cur); }
        if (!has_next) break;
#pragma unroll
        for (int a = 0; a < 2; ++a)
#pragma unroll
            for (int b = 0; b < 2; ++b)
#pragma unroll
                for (int m = 0; m < 4; ++m)
#pragma unroll
                    for (int n = 0; n < 2; ++n) acc[a][b][m][n] = (f32x4){0.f, 0.f, 0.f, 0.f};
        cur = nxt; cA = nA; cB = nB; ++ui;
        if constexpr (ALIGN_EPI) { if (wr == 1) PG8_BAR; }
    }
    PG8_WAIT_V(0);
    if constexpr (!ALIGN_EPI) { if (wr == 0) PG8_BAR; }
    PG8_BAR;
    if constexpr (Epi::AFTER_DRAIN) { E.fused(acc, cur, wr, wc, fr, fq, lds, wid, lane); S.done(cur); }
#undef PG8_SA
#undef PG8_SB
#undef PG8_STAGE
#undef PG8_LDA
#undef PG8_LDB
#undef PG8_MMA
#undef PG8_WAIT_V
#undef PG8_WAIT_L
#undef PG8_BAR
#undef PG8_SCHED
}
}
#ifndef PG8_SP2
#define PG8_SP2 true
#endif
#ifndef PG8_ALIGN
#define PG8_ALIGN true
#endif
#ifndef MK_MULTI
#define MK_MULTI 0
#endif

constexpr int BATCH = 8, SEQ = 8192, DM = 1024, FF = 4096, M = BATCH * SEQ;
constexpr int ZLD = 4352;
constexpr int Z_QA = 0, Z_KA = 512, Z_VA = 640, Z_QB = 768, Z_KB = 1280, Z_VB = 1792, Z_GA = 2304, Z_GB = 3328;
constexpr float EPS = 1e-6f, LOG2E = 1.4426950408889634f;
constexpr int NWAVES = 8, NTHREADS = 512;
constexpr size_t MiB = 1u << 20;
constexpr size_t WS_SS1 = 0, WS_SS2 = 256 * 1024, WS_CNT = 512 * 1024, WS_BAR = 768 * 1024, WS_BAR_BYTES = 16384;
constexpr size_t WS_WIN = 1 * MiB;
constexpr size_t WS_WPA = 10 * MiB, WS_WPB = 11 * MiB;
constexpr size_t WS_WOUT = 12 * MiB;
constexpr size_t WS_WUP = 14 * MiB;
constexpr size_t WS_WDN = 22 * MiB;
constexpr size_t WS_XN = 32 * MiB;
constexpr size_t WS_YA = 160 * MiB, WS_YB = 224 * MiB;
constexpr size_t WS_X2 = 160 * MiB;
constexpr size_t WS_MG = 288 * MiB;
constexpr size_t WS_Z = 416 * MiB;
constexpr size_t WS_END = 960 * MiB;
constexpr int LDS_BYTES = 155648;
#define LAS __attribute__((address_space(3)))
typedef unsigned short bf16;
typedef unsigned v4u __attribute__((ext_vector_type(4)));
typedef unsigned v2u __attribute__((ext_vector_type(2)));
typedef float f32x4 __attribute__((ext_vector_type(4)));
typedef short bf16x8 __attribute__((ext_vector_type(8)));
typedef short s16x4 __attribute__((ext_vector_type(4)));
#define LDS_WAIT() asm volatile("s_waitcnt lgkmcnt(0)" ::: "memory")
__device__ __forceinline__ unsigned f2bf(float f) { unsigned u = __builtin_bit_cast(unsigned, f); return (u + 0x7fffu + ((u >> 16) & 1u)) >> 16; }
__device__ __forceinline__ unsigned pk2(float lo, float hi) { return pg8::cvt_pk_bf16(lo, hi); }
__device__ __forceinline__ float wave_sum(float v) {
#pragma unroll
    for (int o = 1; o < 64; o <<= 1) v += __shfl_xor(v, o);
    return v;
}
__device__ __forceinline__ size_t tmo(int row, int ct, int nct) { return ((size_t)(row >> 8) * nct + ct) * 32768 + (size_t)(row & 255) * 128; }
__device__ __forceinline__ void p0_transpose_item(const float* W, int K, int N, bf16* WT, LAS float* scr, int item, int lane, const float* gk = nullptr, int ldw = 0, int koff = 0) {
    if (ldw == 0) ldw = K;
    const int nblk = N / 32, kb = item / nblk, nb = item % nblk, k0 = 64 * kb, n0 = 32 * nb;
    float wv[32];
    const float* wp = W + (size_t)(k0 + (lane >> 5)) * N + n0 + (lane & 31);
#pragma unroll
    for (int i = 0; i < 32; ++i) wv[i] = __builtin_nontemporal_load(wp + (size_t)(2 * i) * N);
#pragma unroll
    for (int i = 0; i < 32; ++i) { const int kk = 2 * i + (lane >> 5); scr[kk * 33 + (lane & 31)] = wv[i] * (gk ? gk[k0 + kk] : 1.0f); }
    LDS_WAIT(); asm volatile("" ::: "memory");
    const int c = lane & 7;
#pragma unroll
    for (int j = 0; j < 4; ++j) { const int n = (lane >> 3) + 8 * j; const LAS float* s = scr + (8 * c) * 33 + n;
        v4u o; o.x = pk2(s[0 * 33], s[1 * 33]); o.y = pk2(s[2 * 33], s[3 * 33]); o.z = pk2(s[4 * 33], s[5 * 33]); o.w = pk2(s[6 * 33], s[7 * 33]);
        *(v4u*)((unsigned char*)WT + tmo(n0 + n, (koff + k0) >> 6, ldw >> 6) + 16 * c) = o; }
    LDS_WAIT(); asm volatile("" ::: "memory");
}
__device__ __forceinline__ void rms_row_to_bf16(const float* xrow, const float* g, bf16* orow, int lane) {
    const f32x4* xr = (const f32x4*)xrow + lane; const f32x4* gr = (const f32x4*)g + lane;
    f32x4 v[4]; float s = 0.f;
#pragma unroll
    for (int j = 0; j < 4; ++j) { v[j] = xr[64 * j]; s += (v[j].x * v[j].x + v[j].y * v[j].y) + (v[j].z * v[j].z + v[j].w * v[j].w); }
    const float rstd = 1.0f / sqrtf(wave_sum(s) * (1.f / DM) + EPS);
    unsigned long long* o8 = (unsigned long long*)orow + lane;
#pragma unroll
    for (int j = 0; j < 4; ++j) { const f32x4 gg = gr[64 * j]; const f32x4 t = v[j] * rstd * gg;
        o8[64 * j] = (unsigned long long)pk2(t.x, t.y) | ((unsigned long long)pk2(t.z, t.w) << 32); }
}
__device__ __forceinline__ int swz(int row, int chunk) { return row * 128 + ((chunk ^ (row & 7)) << 4); }
__device__ __forceinline__ s16x4 vtr(const LAS unsigned char* p) { return __builtin_bit_cast(s16x4, __builtin_amdgcn_ds_read_tr16_b64_v4i16((LAS s16x4*)p)); }
#define MFMA16(a, b, c) __builtin_amdgcn_mfma_f32_16x16x32_bf16((a), (b), (c), 0, 0, 0)

__device__ __forceinline__ void qk_step(const LAS unsigned char* Kl, int rb0, int rb1, int lq, int g, bf16x8 qf0, bf16x8 qf1, f32x4& S0, f32x4& S1) {
    const bf16x8 k00 = *(const LAS bf16x8*)(Kl + swz(rb0 + lq, g)), k01 = *(const LAS bf16x8*)(Kl + swz(rb0 + lq, 4 + g));
    const bf16x8 k10 = *(const LAS bf16x8*)(Kl + swz(rb1 + lq, g)), k11 = *(const LAS bf16x8*)(Kl + swz(rb1 + lq, 4 + g));
    const f32x4 z = {0.f, 0.f, 0.f, 0.f};
    S0 = MFMA16(k00, qf0, z); S0 = MFMA16(k01, qf1, S0);
    S1 = MFMA16(k10, qf0, z); S1 = MFMA16(k11, qf1, S1);
}
__device__ __forceinline__ void pv_step(const LAS unsigned char* Vl, int rb0, int rb1, int lane, int g, const f32x4& P0, const f32x4& P1, f32x4 (&O)[4]) {
    v4u pw; pw.x = pk2(P0[0], P0[1]); pw.y = pk2(P0[2], P0[3]); pw.z = pk2(P1[0], P1[1]); pw.w = pk2(P1[2], P1[3]);
    const bf16x8 pb = __builtin_bit_cast(bf16x8, pw);
    const int i = lane & 15, rq = i >> 2, p = i & 3;
    const int r0 = rb0 + 4 * g + rq, r1 = rb1 + 4 * g + rq;
#pragma unroll
    for (int db = 0; db < 4; ++db) {
        const s16x4 lo = vtr(Vl + swz(r0, 2 * db + (p >> 1)) + 8 * (p & 1));
        const s16x4 hi = vtr(Vl + swz(r1, 2 * db + (p >> 1)) + 8 * (p & 1));
        const bf16x8 vt = (bf16x8){lo[0], lo[1], lo[2], lo[3], hi[0], hi[1], hi[2], hi[3]};
        O[db] = MFMA16(vt, pb, O[db]);
    }
}
__device__ __forceinline__ void qk_at(const LAS unsigned char* kp0, const LAS unsigned char* kp1, int off, bf16x8 qf0, bf16x8 qf1, f32x4& S0, f32x4& S1) {
    const bf16x8 k00 = *(const LAS bf16x8*)(kp0 + off), k01 = *(const LAS bf16x8*)(kp1 + off);
    const bf16x8 k10 = *(const LAS bf16x8*)(kp0 + off + 2048), k11 = *(const LAS bf16x8*)(kp1 + off + 2048);
    const f32x4 z = {0.f, 0.f, 0.f, 0.f};
    S0 = MFMA16(k00, qf0, z); S0 = MFMA16(k01, qf1, S0);
    S1 = MFMA16(k10, qf0, z); S1 = MFMA16(k11, qf1, S1);
}
__device__ __forceinline__ void pv_at(const LAS unsigned char* const (&vp)[4], int off, const f32x4& P0, const f32x4& P1, f32x4 (&O)[4]) {
    v4u pw; pw.x = pk2(P0[0], P0[1]); pw.y = pk2(P0[2], P0[3]); pw.z = pk2(P1[0], P1[1]); pw.w = pk2(P1[2], P1[3]);
    const bf16x8 pb = __builtin_bit_cast(bf16x8, pw);
#pragma unroll
    for (int db = 0; db < 4; ++db) {
        const s16x4 lo = vtr(vp[db] + off), hi = vtr(vp[db] + off + 2048);
        const bf16x8 vt = (bf16x8){lo[0], lo[1], lo[2], lo[3], hi[0], hi[1], hi[2], hi[3]};
        O[db] = MFMA16(vt, pb, O[db]);
    }
}
__device__ __forceinline__ float xrow16_max(float x) {
    auto s = __builtin_amdgcn_permlane16_swap(__float_as_uint(x), __float_as_uint(x), false, false);
    x = fmaxf(__uint_as_float(s[0]), __uint_as_float(s[1]));
    auto t = __builtin_amdgcn_permlane32_swap(__float_as_uint(x), __float_as_uint(x), false, false);
    return fmaxf(__uint_as_float(t[0]), __uint_as_float(t[1]));
}
__device__ __forceinline__ float xrow16_sum(float x) {
    auto s = __builtin_amdgcn_permlane16_swap(__float_as_uint(x), __float_as_uint(x), false, false);
    x = __uint_as_float(s[0]) + __uint_as_float(s[1]);
    auto t = __builtin_amdgcn_permlane32_swap(__float_as_uint(x), __float_as_uint(x), false, false);
    return __uint_as_float(t[0]) + __uint_as_float(t[1]);
}
__device__ __forceinline__ void softmax_step(f32x4& s0, f32x4& s1, float& m, float& l, f32x4 (&O)[4]) {
    float t = fmaxf(fmaxf(fmaxf(s0[0], s0[1]), fmaxf(s0[2], s0[3])), fmaxf(fmaxf(s1[0], s1[1]), fmaxf(s1[2], s1[3])));
    t = xrow16_max(t);
    const float mn = fmaxf(m, t), alpha = __builtin_amdgcn_exp2f(m - mn);
    m = mn;
#pragma unroll
    for (int k = 0; k < 4; ++k) { s0[k] = __builtin_amdgcn_exp2f(s0[k] - mn); s1[k] = __builtin_amdgcn_exp2f(s1[k] - mn); }
    l = l * alpha + ((s0[0] + s0[1]) + (s0[2] + s0[3])) + ((s1[0] + s1[1]) + (s1[2] + s1[3]));
#pragma unroll
    for (int db = 0; db < 4; ++db) O[db] *= alpha;
}
__device__ __forceinline__ void store_o(bf16* yrow, int g, float l, const f32x4 (&O)[4]) {
    const float inv = 1.0f / xrow16_sum(l);
    unsigned wx[4], wy[4];
#pragma unroll
    for (int db = 0; db < 4; ++db) { wx[db] = pk2(O[db][0] * inv, O[db][1] * inv); wy[db] = pk2(O[db][2] * inv, O[db][3] * inv); }
#pragma unroll
    for (int p = 0; p < 2; ++p) {
        auto rx = __builtin_amdgcn_permlane16_swap(wx[2 * p], wx[2 * p + 1], false, false); wx[2 * p] = rx[0]; wx[2 * p + 1] = rx[1];
        auto ry = __builtin_amdgcn_permlane16_swap(wy[2 * p], wy[2 * p + 1], false, false); wy[2 * p] = ry[0]; wy[2 * p + 1] = ry[1]; }
#pragma unroll
    for (int p = 0; p < 2; ++p) {
        auto rx = __builtin_amdgcn_permlane32_swap(wx[p], wx[p + 2], false, false); wx[p] = rx[0]; wx[p + 2] = rx[1];
        auto ry = __builtin_amdgcn_permlane32_swap(wy[p], wy[p + 2], false, false); wy[p] = ry[0]; wy[p + 2] = ry[1]; }
    v4u lo = {wx[0], wy[0], wx[1], wy[1]}, hi = {wx[2], wy[2], wx[3], wy[3]};
    *(v4u*)(yrow + 16 * g) = lo; *(v4u*)(yrow + 16 * g + 8) = hi;
}

constexpr int A_ROWS = 400, A_KOFF = 0, A_VOFF = A_ROWS * 128;
template <bool MASK> __device__ __forceinline__ void a_scores(f32x4& S0, f32x4& S1, float basef, float c1, float slope2, int krow0, int kstart) {
#pragma unroll
    for (int r = 0; r < 4; ++r) {
        const float d0 = fabsf(basef - (float)r), d1 = fabsf(basef - (float)(16 + r));
        const float v0 = S0[r] - slope2 * d0, v1 = S1[r] - slope2 * d1;
        if (MASK) { const int p0 = kstart + krow0 + r, p1 = p0 + 16;
            S0[r] = (d0 <= 128.f && p0 >= 0 && p0 < SEQ) ? v0 : -INFINITY; S1[r] = (d1 <= 128.f && p1 >= 0 && p1 < SEQ) ? v1 : -INFINITY; }
        else { S0[r] = v0; S1[r] = v1; }
    }
}
__device__ __forceinline__ void attn_a_prefetch(const bf16* Z, int unit, v4u (&kr)[7], v4u (&vr)[7]) {
    const int tid = threadIdx.x; const int ib = ((unit & 63) + 16 * (unit >> 8)) & 63, kvh = (unit >> 6) & 1, b = unit >> 7;
    const size_t tok0 = (size_t)b * SEQ; const int kstart = (ib - 1) * 128;
#pragma unroll
    for (int k = 0; k < 7; ++k) { const int it = tid + k * NTHREADS; const int row = it >> 3, ch = it & 7, pos = kstart + row;
        kr[k] = (v4u){0u, 0u, 0u, 0u}; vr[k] = (v4u){0u, 0u, 0u, 0u};
        if (it < A_ROWS * 8 && row < 384 && pos >= 0 && pos < SEQ) { const int t = (int)tok0 + pos; kr[k] = *(const v4u*)((const unsigned char*)Z + tmo(t, Z_KA / 64 + kvh, ZLD / 64) + ch * 16); vr[k] = *(const v4u*)((const unsigned char*)Z + tmo(t, Z_VA / 64 + kvh, ZLD / 64) + ch * 16); } }
}
__device__ __forceinline__ void attn_a_commit(LAS unsigned char* lds, const v4u (&kr)[7], const v4u (&vr)[7]) {
    const int tid = threadIdx.x; LAS unsigned char* Kl = lds + A_KOFF; LAS unsigned char* Vl = lds + A_VOFF;
#pragma unroll
    for (int k = 0; k < 7; ++k) { const int it = tid + k * NTHREADS; const int row = it >> 3, ch = it & 7;
        if (it < A_ROWS * 8) { *(LAS v4u*)(Kl + swz(row, ch)) = kr[k]; *(LAS v4u*)(Vl + swz(row, ch)) = vr[k]; } }
}
__device__ __forceinline__ void attn_a_unit(LAS unsigned char* lds, const bf16* Z, bf16* Y, const float* sink, int unit) {
    const int tid = threadIdx.x, lane = tid & 63, wid = tid >> 6, lq = lane & 15, g = lane >> 4;
    const int ib = ((unit & 63) + 16 * (unit >> 8)) & 63, kvh = (unit >> 6) & 1, b = unit >> 7;
    const size_t tok0 = (size_t)b * SEQ; const int kstart = (ib - 1) * 128;
    LAS unsigned char* Kl = lds + A_KOFF; LAS unsigned char* Vl = lds + A_VOFF;
    const int hq = kvh * 4 + (wid >> 1);
    const float slope2 = __builtin_amdgcn_exp2f(-(float)(hq + 1)) * LOG2E, sink2 = sink[hq] * LOG2E, c1 = 0.125f * LOG2E;
    const bool edge = (ib == 0) || (ib == 63);
    for (int bp = 0; bp < 2; ++bp) {
        const int qoffA = (wid & 1) * 64 + bp * 32, qoffB = qoffA + 16;
        const size_t qtokA = tok0 + ib * 128 + qoffA + lq, qtokB = qtokA + 16;
        const unsigned char* qpA = (const unsigned char*)Z + tmo((int)qtokA, Z_QA / 64 + hq, ZLD / 64) + 16 * g; const unsigned char* qpB = qpA + 16 * 128;
        const bf16x8 qA0 = *(const bf16x8*)qpA, qA1 = *(const bf16x8*)(qpA + 64), qB0 = *(const bf16x8*)qpB, qB1 = *(const bf16x8*)(qpB + 64);
        float mA = sink2, lA = (g == 0) ? 1.0f : 0.0f, mB = sink2, lB = lA;
        f32x4 OA[4], OB[4];
#pragma unroll
        for (int d = 0; d < 4; ++d) { OA[d] = (f32x4){0.f, 0.f, 0.f, 0.f}; OB[d] = (f32x4){0.f, 0.f, 0.f, 0.f}; }
        if (edge) {
        for (int st = 0; st < 9; ++st) {
            const int rbA = qoffA + 32 * st, rbB = rbA + 16;
            f32x4 SA0, SA1, SB0, SB1;
            qk_step(Kl, rbA, rbA + 16, lq, g, qA0, qA1, SA0, SA1);
            qk_step(Kl, rbB, rbB + 16, lq, g, qB0, qB1, SB0, SB1);
            const float basef = (float)(128 + lq - 32 * st - 4 * g);
            a_scores<true>(SA0, SA1, basef, c1, slope2, rbA + 4 * g, kstart); a_scores<true>(SB0, SB1, basef, c1, slope2, rbB + 4 * g, kstart);
            softmax_step(SA0, SA1, mA, lA, OA);
            softmax_step(SB0, SB1, mB, lB, OB);
            pv_step(Vl, rbA, rbA + 16, lane, g, SA0, SA1, OA);
            pv_step(Vl, rbB, rbB + 16, lane, g, SB0, SB1, OB);
        }
        } else {
        const LAS unsigned char* kp0 = Kl + swz(qoffA + lq, g); const LAS unsigned char* kp1 = Kl + swz(qoffA + lq, 4 + g);
        const LAS unsigned char* vp[4];
        { const int i = lane & 15, rq4 = i >> 2, p = i & 3;
#pragma unroll
          for (int db = 0; db < 4; ++db) vp[db] = Vl + swz(qoffA + 4 * g + rq4, 2 * db + (p >> 1)) + 8 * (p & 1); }
        float basef = (float)(128 + lq - 4 * g);
#define A_STEP(MASKED, ST) do { f32x4 SA0, SA1, SB0, SB1; \
            qk_at(kp0, kp1, 0, qA0, qA1, SA0, SA1); qk_at(kp0, kp1, 2048, qB0, qB1, SB0, SB1); \
            if (MASKED) { const int rbA_ = qoffA + 32 * (ST); a_scores<true>(SA0, SA1, basef, c1, slope2, rbA_ + 4 * g, kstart); a_scores<true>(SB0, SB1, basef, c1, slope2, rbA_ + 16 + 4 * g, kstart); } \
            else { a_scores<false>(SA0, SA1, basef, c1, slope2, 0, 0); a_scores<false>(SB0, SB1, basef, c1, slope2, 0, 0); } \
            softmax_step(SA0, SA1, mA, lA, OA); softmax_step(SB0, SB1, mB, lB, OB); \
            pv_at(vp, 0, SA0, SA1, OA); pv_at(vp, 2048, SB0, SB1, OB); \
            kp0 += 4096; kp1 += 4096; basef -= 32.f; _Pragma("unroll") for (int db_ = 0; db_ < 4; ++db_) vp[db_] += 4096; } while (0)
        A_STEP(true, 0);
        for (int st = 1; st < 8; ++st) A_STEP(false, st);
        A_STEP(true, 8);
#undef A_STEP
        }
        store_o((bf16*)((unsigned char*)Y + tmo((int)qtokA, hq, 16)), g, lA, OA);
        store_o((bf16*)((unsigned char*)Y + tmo((int)qtokB, hq, 16)), g, lB, OB);
    }
}
constexpr int B_ROWS = 9 * 64, B_KOFF = 0, B_VOFF = B_ROWS * 128, B_TOFF = 2 * B_ROWS * 128, B_TREAL = 544, B_TSIZE = 800;
static_assert(B_TOFF + B_TSIZE * 4 <= LDS_BYTES && A_VOFF + A_ROWS * 128 <= LDS_BYTES, "LDS map");
__device__ __forceinline__ int clampi(int v, int lo, int hi) { return v < lo ? lo : (v > hi ? hi : v); }
__device__ __forceinline__ void attn_b_prefetch(const bf16* Z, const float* rpb, int unit, v4u (&kr)[9], v4u (&vr)[9], float (&tr)[2]) {
    const int tid = threadIdx.x; const int rp = unit & 63, h = (unit >> 6) & 7, b = unit >> 9;
    const size_t tok0 = (size_t)b * SEQ; const int R0 = clampi(2 * rp - 4, 0, 120);
#pragma unroll
    for (int k = 0; k < 9; ++k) { const int it = tid + k * NTHREADS; const int row = it >> 3, ch = it & 7, gr = R0 + (row >> 6);
        kr[k] = (v4u){0u, 0u, 0u, 0u}; vr[k] = (v4u){0u, 0u, 0u, 0u};
        if (gr < 128) { const int t = (int)tok0 + gr * 64 + (row & 63); kr[k] = *(const v4u*)((const unsigned char*)Z + tmo(t, Z_KB / 64 + h, ZLD / 64) + ch * 16); vr[k] = *(const v4u*)((const unsigned char*)Z + tmo(t, Z_VB / 64 + h, ZLD / 64) + ch * 16); } }
#pragma unroll
    for (int k = 0; k < 2; ++k) { const int it = tid + k * NTHREADS, e = it - 16, dr = e >> 5, dc = e & 31;
        tr[k] = (it >= B_TREAL) ? -INFINITY : ((e >= 0 && dr < 15 && dc < 31) ? rpb[h * 465 + dr * 31 + dc] * LOG2E : 0.f); }
}
__device__ __forceinline__ void attn_b_commit(LAS unsigned char* lds, const v4u (&kr)[9], const v4u (&vr)[9], const float (&tr)[2]) {
    const int tid = threadIdx.x; LAS unsigned char* Kl = lds + B_KOFF; LAS unsigned char* Vl = lds + B_VOFF; LAS float* T = (LAS float*)(lds + B_TOFF);
#pragma unroll
    for (int k = 0; k < 9; ++k) { const int it = tid + k * NTHREADS; const int row = it >> 3, ch = it & 7;
        *(LAS v4u*)(Kl + swz(row, ch)) = kr[k]; *(LAS v4u*)(Vl + swz(row, ch)) = vr[k]; }
#pragma unroll
    for (int k = 0; k < 2; ++k) { const int it = tid + k * NTHREADS; if (it < B_TSIZE) T[it] = tr[k]; }
}
__device__ __forceinline__ void attn_b_unit(LAS unsigned char* lds, const bf16* Z, bf16* Y, int unit) {
    const int tid = threadIdx.x, lane = tid & 63, wid = tid >> 6, lq = lane & 15, g = lane >> 4;
    const int rp = unit & 63, h = (unit >> 6) & 7, b = unit >> 9;
    const size_t tok0 = (size_t)b * SEQ;
    const int R0 = clampi(2 * rp - 4, 0, 120);
    LAS unsigned char* Kl = lds + B_KOFF; LAS unsigned char* Vl = lds + B_VOFF; LAS float* T = (LAS float*)(lds + B_TOFF);
    const int rq = 2 * rp + (wid >> 2), cb = wid & 3, c = 16 * cb + lq;
    const int r0q = clampi(rq - 4, 0, 120), kc0 = clampi(16 * cb - 8, 0, 32), cs = clampi(c - 8, 0, 48);
    const size_t qtok = tok0 + (size_t)rq * 64 + c;
    const unsigned char* qp = (const unsigned char*)Z + tmo((int)qtok, Z_QB / 64 + h, ZLD / 64) + 16 * g;
    const bf16x8 qf0 = *(const bf16x8*)qp, qf1 = *(const bf16x8*)(qp + 64);
    float m0 = -1e30f, l0 = 0.f, m1 = -1e30f, l1 = 0.f;
    f32x4 O0[4], O1[4];
#pragma unroll
    for (int d = 0; d < 4; ++d) { O0[d] = (f32x4){0.f, 0.f, 0.f, 0.f}; O1[d] = (f32x4){0.f, 0.f, 0.f, 0.f}; }
    const int kcl = kc0 + 4 * g;
    const int tb = 16 + (kcl - c + 15);
    const int Rb = (r0q - R0) * 64 + kc0;
    const LAS unsigned char* kp0 = Kl + swz(Rb + lq, g); const LAS unsigned char* kp1 = Kl + swz(Rb + lq, 4 + g);
    const LAS unsigned char* vp[4];
    { const int i = lane & 15, rq4 = i >> 2, p = i & 3;
#pragma unroll
      for (int db = 0; db < 4; ++db) vp[db] = Vl + swz(Rb + 4 * g + rq4, 2 * db + (p >> 1)) + 8 * (p & 1); }
    const LAS float* T0 = T + tb + (r0q - rq + 7) * 32;
    const LAS float* tpa[4]; const LAS float* tpb[4];
#pragma unroll
    for (int r = 0; r < 4; ++r) { const int kca = kcl + r, kcb = kca + 16;
        tpa[r] = (kca >= cs && kca <= cs + 15) ? T0 + r : T + B_TREAL; tpb[r] = (kcb >= cs && kcb <= cs + 15) ? T0 + 16 + r : T + B_TREAL; }
#pragma unroll
    for (int st = 0; st < 4; ++st) {
        const int offA = st * 8192, offB = offA + 4 * 8192;
        f32x4 SA0, SA1, SB0, SB1;
        qk_at(kp0, kp1, offA, qf0, qf1, SA0, SA1);
        qk_at(kp0, kp1, offB, qf0, qf1, SB0, SB1);
#pragma unroll
        for (int r = 0; r < 4; ++r) {
            SA0[r] += tpa[r][st * 32]; SA1[r] += tpb[r][st * 32]; SB0[r] += tpa[r][st * 32 + 128]; SB1[r] += tpb[r][st * 32 + 128];
        }
        softmax_step(SA0, SA1, m0, l0, O0);
        softmax_step(SB0, SB1, m1, l1, O1);
        pv_at(vp, offA, SA0, SA1, O0);
        pv_at(vp, offB, SB0, SB1, O1);
    }
    { const float mm = fmaxf(m0, m1), a0 = __builtin_amdgcn_exp2f(m0 - mm), a1 = __builtin_amdgcn_exp2f(m1 - mm);
      l0 = l0 * a0 + l1 * a1;
#pragma unroll
      for (int d = 0; d < 4; ++d) O0[d] = O0[d] * a0 + O1[d] * a1; }
    store_o((bf16*)((unsigned char*)Y + tmo((int)qtok, 8 + h, 16)), g, l0, O0);
}

#define XB_TMO      128
#define XB_XCNT(j)  (256  + 64 * (j))
#define XB_XSUB(j)  (1280 + 64 * (j))
#define XB_XGEN(j)  (2304 + 64 * (j))
#define XB_TOP      3328
#define XB_TOPGEN   3392
#define XCD_BAR_WORDS 3456
#define XB_SPIN_CAP (1u << 18)

__device__ __forceinline__ unsigned xb_ld(unsigned* p)              { return __hip_atomic_load(p, __ATOMIC_RELAXED, __HIP_MEMORY_SCOPE_AGENT); }
__device__ __forceinline__ unsigned xb_add(unsigned* p, unsigned v) { return __hip_atomic_fetch_add(p, v, __ATOMIC_RELAXED, __HIP_MEMORY_SCOPE_AGENT); }
__device__ __forceinline__ unsigned xb_xcc_id() { return (unsigned)__builtin_amdgcn_s_getreg((3 << 11) | 20) & 0xFu; }
#define XB_SPIN(cond, bar) do { unsigned _sp = 0; while (cond) { __builtin_amdgcn_s_sleep(1); \
    if ((++_sp & 255u) == 0u) { if (xb_ld(&(bar)[XB_TMO])) break; if (_sp > XB_SPIN_CAP) { atomicAdd(&(bar)[XB_TMO], 1u); break; } } } } while (0)

struct XcdBarrier {
    unsigned* bar; unsigned x;
    volatile LAS unsigned* st;
};

__device__ __forceinline__ XcdBarrier xcd_barrier_post(unsigned* bar, volatile LAS unsigned* st) {
    XcdBarrier b; b.bar = bar; b.x = xb_xcc_id(); b.st = st;
    if (threadIdx.x == 0) (void)xb_add(&bar[XB_XCNT(b.x)], 1u);
    return b;
}
__device__ __forceinline__ void xcd_barrier_complete(unsigned* bar, unsigned x, unsigned& nloc, unsigned& nx) {
    const unsigned G = gridDim.x * gridDim.y * gridDim.z;
    unsigned sum, cnt, mine, sp = 0u;
    for (;;) {
        sum = 0u; cnt = 0u; mine = 0u;
#pragma unroll
        for (unsigned j = 0; j < 16; ++j) { const unsigned c = xb_ld(&bar[XB_XCNT(j)]); sum += c; cnt += (c > 0u) ? 1u : 0u; mine = (j == x) ? c : mine; }
        if (sum == G) break;
        __builtin_amdgcn_s_sleep(1);
        if ((++sp & 255u) == 0u) { if (xb_ld(&bar[XB_TMO])) break; if (sp > XB_SPIN_CAP) { atomicAdd(&bar[XB_TMO], 1u); break; } }
    }
    nloc = mine > 0u ? mine : 1u; nx = cnt > 0u ? cnt : 1u;
}

__device__ __forceinline__ void xcd_barrier(const XcdBarrier& b) {
    asm volatile("s_waitcnt vmcnt(0)" ::: "memory");
    __syncthreads();
    if (threadIdx.x == 0) {
        unsigned* bar = b.bar;
        __builtin_amdgcn_s_waitcnt(0);
        unsigned nloc = b.st[0], nx = b.st[1];
        if (nloc == 0u) { xcd_barrier_complete(bar, b.x, nloc, nx); b.st[0] = nloc; b.st[1] = nx; }
        const unsigned old = xb_add(&bar[XB_XSUB(b.x)], 1u);
        const unsigned gen = old / nloc;
        if (old + 1u == (gen + 1u) * nloc) {
            __builtin_amdgcn_fence(__ATOMIC_RELEASE, "agent");
            asm volatile("s_waitcnt vmcnt(0)" ::: "memory");
            const unsigned og = xb_add(&bar[XB_TOP], 1u);
            const unsigned tg = og / nx;
            if (og + 1u == (tg + 1u) * nx) xb_add(&bar[XB_TOPGEN], 1u);
            else XB_SPIN(xb_ld(&bar[XB_TOPGEN]) == tg, bar);
            __builtin_amdgcn_fence(__ATOMIC_ACQUIRE, "agent");
            xb_add(&bar[XB_XGEN(b.x)], 1u);
            asm volatile("s_waitcnt vmcnt(0)" ::: "memory");
        } else {
            XB_SPIN(xb_ld(&bar[XB_XGEN(b.x)]) == gen, bar);
            __builtin_amdgcn_fence(__ATOMIC_ACQUIRE, "agent");
            asm volatile("s_waitcnt vmcnt(0)" ::: "memory");
        }
    }
    __syncthreads();
}

struct Args { const float* in[13]; float* out; unsigned char* ws; int ph_lo, ph_hi; };
constexpr int N_PHASES = 8;
__global__ void __launch_bounds__(NTHREADS, 2) mk_fwd(Args args) {
    extern __shared__ __attribute__((aligned(16))) unsigned char lds_raw[];
    LAS unsigned char* lds = (LAS unsigned char*)lds_raw;
    const int tid = threadIdx.x, lane = tid & 63, wave = __builtin_amdgcn_readfirstlane(tid >> 6);
    const int G = gridDim.x, bx = blockIdx.x;
    const int vcu = (G % 8 == 0) ? (bx % 8) * (G / 8) + bx / 8 : bx;
    unsigned char* ws = args.ws;
    const float* x = args.in[0]; const float* norm_mix = args.in[1]; const float* w_in = args.in[2]; const float* b_gate = args.in[3];
    const float* sink = args.in[4]; const float* rpb = args.in[5]; const float* w_pa = args.in[6]; const float* w_pb = args.in[7];
    const float* w_out = args.in[8]; const float* norm_mlp = args.in[9]; const float* w_up = args.in[10]; const float* w_dn = args.in[11]; const float* norm_final = args.in[12];
    float* out = args.out;
    float* ss1 = (float*)(ws + WS_SS1); float* ss2 = (float*)(ws + WS_SS2); unsigned* cnt6 = (unsigned*)(ws + WS_CNT);
    bf16 *Win_t = (bf16*)(ws + WS_WIN), *Wpa_t = (bf16*)(ws + WS_WPA), *Wpb_t = (bf16*)(ws + WS_WPB), *Wout_t = (bf16*)(ws + WS_WOUT), *Wup_t = (bf16*)(ws + WS_WUP), *Wdn_t = (bf16*)(ws + WS_WDN);
    bf16 *XN = (bf16*)(ws + WS_XN), *YA = (bf16*)(ws + WS_YA), *YB = (bf16*)(ws + WS_YB), *MG = (bf16*)(ws + WS_MG), *X2 = (bf16*)(ws + WS_X2), *Zb = (bf16*)(ws + WS_Z), *Hb = (bf16*)(ws + WS_Z);
    const int lo = args.ph_lo, hi = args.ph_hi;
    volatile LAS unsigned* bst = (volatile LAS unsigned*)(lds + LDS_BYTES - 16);
    if (tid < 4) bst[tid] = 0u;
    __syncthreads();
    XcdBarrier bar = xcd_barrier_post((unsigned*)(ws + WS_BAR), bst);
#define IN(k) (lo <= (k) && (k) < hi)
#define SEAM(k) do { if (IN(k) && IN((k) + 1)) { if (hi > N_PHASES) cg::this_grid().sync(); else xcd_barrier(bar); } } while (0)

    if (IN(0)) {
        LAS float* scr = (LAS float*)(lds + wave * 16384);
        const int gw = vcu * NWAVES + wave, NGW = G * NWAVES;
        constexpr int I_IN = (DM / 64) * (ZLD / 32), I_P = (512 / 64) * (DM / 32), I_O = (DM / 64) * (DM / 32), I_U = (DM / 64) * (FF / 32), I_D = (FF / 64) * (DM / 32);
        constexpr int NITEMS = I_IN + 2 * I_P + I_O + I_U + I_D;
        for (int it = gw; it < NITEMS; it += NGW) {
            int r = it;
            if (r < I_IN) { p0_transpose_item(w_in, DM, ZLD, Win_t, scr, r, lane); continue; } r -= I_IN;
            if (r < I_P) { p0_transpose_item(w_pa, 512, DM, Wpa_t, scr, r, lane, nullptr, 1024, 0); continue; } r -= I_P;
            if (r < I_P) { p0_transpose_item(w_pb, 512, DM, Wpa_t, scr, r, lane, nullptr, 1024, 512); continue; } r -= I_P;
            if (r < I_O) { p0_transpose_item(w_out, DM, DM, Wout_t, scr, r, lane); continue; } r -= I_O;
            if (r < I_U) { p0_transpose_item(w_up, DM, FF, Wup_t, scr, r, lane, norm_mlp); continue; } r -= I_U;
            p0_transpose_item(w_dn, FF, DM, Wdn_t, scr, r, lane);
        }
        for (int i = bx * NTHREADS + tid; i < M; i += G * NTHREADS) { ss1[i] = 0.f; ss2[i] = 0.f; if (i < 256 * 16) cnt6[i] = 0u; }
        {
            const f32x4* gr = (const f32x4*)norm_mix + lane; f32x4 gg[4];
#pragma unroll
            for (int j = 0; j < 4; ++j) gg[j] = gr[64 * j];
            for (int mrow = gw; mrow < M; mrow += 4 * NGW) {
                f32x4 v[4][4]; float ssq[4];
#pragma unroll
                for (int r = 0; r < 4; ++r) { const f32x4* xr = (const f32x4*)(x + (size_t)min(mrow + r * NGW, M - 1) * DM) + lane;
#pragma unroll
                    for (int j = 0; j < 4; ++j) v[r][j] = __builtin_nontemporal_load(xr + 64 * j); }
#pragma unroll
                for (int r = 0; r < 4; ++r) { float t = 0.f;
#pragma unroll
                    for (int j = 0; j < 4; ++j) t += (v[r][j].x * v[r][j].x + v[r][j].y * v[r][j].y) + (v[r][j].z * v[r][j].z + v[r][j].w * v[r][j].w);
                    ssq[r] = t; }
#pragma unroll
                for (int o = 1; o < 64; o <<= 1) {
#pragma unroll
                    for (int r = 0; r < 4; ++r) ssq[r] += __shfl_xor(ssq[r], o); }
#pragma unroll
                for (int r = 0; r < 4; ++r) { const float rstd = 1.0f / sqrtf(ssq[r] * (1.f / DM) + EPS);
                    unsigned char* o8 = (unsigned char*)XN + tmo(min(mrow + r * NGW, M - 1), lane >> 4, 16) + 8 * (lane & 15);
#pragma unroll
                    for (int j = 0; j < 4; ++j) { const f32x4 t = v[r][j] * rstd * gg[j]; *(unsigned long long*)(o8 + (size_t)j * 4 * 32768) = (unsigned long long)pk2(t.x, t.y) | ((unsigned long long)pk2(t.z, t.w) << 32); } }
            }
        }
        __syncthreads();
    }
    SEAM(0);
    if (IN(1)) {
        pg8::Gemm g{XN, Win_t, M, ZLD, DM}; pg8::StaticOrder S; S.init(M, ZLD, G, bx);
        pg8::EpiPlain E{Zb, ZLD / 64, lds + 131072};
        pg8::gemm_phase<pg8::EpiPlain, pg8::StaticOrder, PG8_ALIGN, PG8_SP2>(lds, g, S, E);
    }
    SEAM(1);
    if (IN(2)) {
        {
            v4u kr[7], vr[7]; int u = vcu; const int NU = BATCH * 2 * 64;
            if (u < NU) attn_a_prefetch(Zb, u, kr, vr);
            for (; u < NU; u += G) {
                attn_a_commit(lds, kr, vr);
                __syncthreads();
                if (u + G < NU) attn_a_prefetch(Zb, u + G, kr, vr);
                asm volatile("" ::: "memory");
                attn_a_unit(lds, Zb, YA, sink, u);
                __syncthreads();
            }
        }
        {
            v4u kr[9], vr[9]; float tr[2]; int u = vcu; const int NU = BATCH * 8 * 64;
            if (u < NU) attn_b_prefetch(Zb, rpb, u, kr, vr, tr);
            for (; u < NU; u += G) {
                attn_b_commit(lds, kr, vr, tr);
                __syncthreads();
                if (u + G < NU) attn_b_prefetch(Zb, rpb, u + G, kr, vr, tr);
                asm volatile("" ::: "memory");
                attn_b_unit(lds, Zb, YA, u);
                __syncthreads();
            }
        }
    }
    SEAM(2);
    if (IN(3)) {
        pg8::Gemm g{YA, Wpa_t, M, DM, DM}; pg8::StaticOrder S; S.init(M, DM, G, bx);
        pg8::EpiGate2 E{MG, Zb, ZLD / 64, Z_GA / 64, Z_GB / 64, b_gate, lds + 131072};
        pg8::gemm_phase<pg8::EpiGate2, pg8::StaticOrder, PG8_ALIGN, PG8_SP2>(lds, g, S, E);
    }
    SEAM(3);
    if (IN(4)) {
        pg8::Gemm g{MG, Wout_t, M, DM, DM}; pg8::StaticOrder S; S.init(M, DM, G, bx);
        pg8::EpiRes1 E{x, XN, ss1, lds + 131072};
        pg8::gemm_phase<pg8::EpiRes1, pg8::StaticOrder, PG8_ALIGN, PG8_SP2>(lds, g, S, E);
    }
    SEAM(4);
    if (IN(5)) {
        pg8::Gemm g{XN, Wup_t, M, FF, DM}; pg8::StaticOrder S; S.init(M, FF, G, bx);
        pg8::EpiUp E{Hb, ss1, EPS, lds + 131072};
        pg8::gemm_phase<pg8::EpiUp, pg8::StaticOrder, PG8_ALIGN, PG8_SP2>(lds, g, S, E);
    }
    SEAM(5);
    if (IN(6)) {
        pg8::Gemm g{Hb, Wdn_t, M, DM, FF}; pg8::StaticOrder S; S.init(M, DM, G, bx);
        if (G == 256 && hi == N_PHASES && PG8_ALIGN) { pg8::EpiResNorm E{XN, out, norm_final, ss2, cnt6, EPS, lds + 131072};
            pg8::gemm_phase<pg8::EpiResNorm, pg8::StaticOrder, PG8_ALIGN, PG8_SP2>(lds, g, S, E); }
        else { pg8::EpiRes2 E{XN, X2, ss2, lds + 131072};
            pg8::gemm_phase<pg8::EpiRes2, pg8::StaticOrder, PG8_ALIGN, PG8_SP2>(lds, g, S, E); }
    }
    const bool fusedNorm = (G == 256 && hi == N_PHASES && PG8_ALIGN);
    if (!fusedNorm) SEAM(6);
    if (IN(7) && !fusedNorm) {
        const int gw = vcu * NWAVES + wave, NGW = G * NWAVES;
        const f32x4* gr = (const f32x4*)norm_final + lane;
        f32x4 gg[4];
#pragma unroll
        for (int j = 0; j < 4; ++j) gg[j] = gr[64 * j];
        for (int mrow = 4 * gw; mrow < M; mrow += 4 * NGW) {
            v2u xv[4][4]; float rstd[4];
#pragma unroll
            for (int r = 0; r < 4; ++r) { const unsigned char* xr = (const unsigned char*)X2 + tmo(mrow + r, lane >> 4, 16) + 8 * (lane & 15);
                rstd[r] = __hip_atomic_load(ss2 + mrow + r, __ATOMIC_RELAXED, __HIP_MEMORY_SCOPE_AGENT);
#pragma unroll
                for (int j = 0; j < 4; ++j) xv[r][j] = __builtin_nontemporal_load((const v2u*)(xr + (size_t)j * 4 * 32768)); }
#pragma unroll
            for (int r = 0; r < 4; ++r) { const float rs = 1.0f / sqrtf(rstd[r] * (1.f / DM) + EPS); f32x4* orow = (f32x4*)(out + (size_t)(mrow + r) * DM) + lane;
#pragma unroll
                for (int j = 0; j < 4; ++j) { const f32x4 v = {__uint_as_float(xv[r][j].x << 16), __uint_as_float(xv[r][j].x & 0xffff0000u), __uint_as_float(xv[r][j].y << 16), __uint_as_float(xv[r][j].y & 0xffff0000u)};
                    __builtin_nontemporal_store(v * rs * gg[j], orow + 64 * j); } }
        }
    }
#undef IN
#undef SEAM
}

extern "C" void kernel_launch(void* const* d_in, const int* in_sizes, int n_in, void* d_out, int out_size, void* d_ws, size_t ws_size, hipStream_t stream) {
    static int grid = 0;
    if (grid == 0) {
        if (n_in != 13 || in_sizes[0] != M * DM || out_size != M * DM || ws_size < WS_END) { fprintf(stderr, "kernel_launch: unexpected shapes (n_in %d in0 %d out %d ws %zu)\n", n_in, n_in > 0 ? in_sizes[0] : -1, out_size, ws_size); grid = -1; return; }
        int dev = 0, cus = 0, per_cu = 0;
        if (hipGetDevice(&dev) != hipSuccess || hipDeviceGetAttribute(&cus, hipDeviceAttributeMultiprocessorCount, dev) != hipSuccess) { grid = -1; return; }
        if (hipFuncSetAttribute((const void*)mk_fwd, hipFuncAttributeMaxDynamicSharedMemorySize, LDS_BYTES) != hipSuccess) { fprintf(stderr, "kernel_launch: hipFuncSetAttribute failed\n"); grid = -1; return; }
        if (hipOccupancyMaxActiveBlocksPerMultiprocessor(&per_cu, (const void*)mk_fwd, NTHREADS, LDS_BYTES) != hipSuccess || per_cu < 1) { fprintf(stderr, "kernel_launch: occupancy query says %d\n", per_cu); per_cu = 1; }
        (void)hipGetLastError();
        grid = cus * per_cu;
    }
    if (grid < 0) return;
    if (hipMemsetAsync((char*)d_ws + WS_BAR, 0, WS_BAR_BYTES, stream) != hipSuccess) { fprintf(stderr, "kernel_launch: hipMemsetAsync failed\n"); return; }
    Args a{};
    for (int i = 0; i < 13; ++i) a.in[i] = (const float*)d_in[i];
    a.out = (float*)d_out; a.ws = (unsigned char*)d_ws;
#if MK_MULTI
    for (int p = 0; p < N_PHASES; ++p) { a.ph_lo = p; a.ph_hi = p + 1; hipLaunchKernelGGL(mk_fwd, dim3(grid), dim3(NTHREADS), LDS_BYTES, stream, a); }
#else
    a.ph_lo = 0; a.ph_hi = N_PHASES;
    void* kargs[] = {&a};
    hipError_t e = hipLaunchCooperativeKernel((const void*)mk_fwd, dim3(grid), dim3(NTHREADS), kargs, LDS_BYTES, stream);
    if (e != hipSuccess) fprintf(stderr, "cooperative launch failed: %s (grid %d)\n", hipGetErrorString(e), grid);
#endif
}
```
